# Optimizing an MI355X kernel written in HIP

```python
import math
import jax, jax.numpy as jnp
from jax import lax
import numpy as np

D_MODEL = 2048
BATCH = 8
SEQ = 2048
DEPTH = 2

GRID_W = 64
CTX_LEN = 256
N_MIXERS = 2
HEAD_DIM = 128
N_HEADS = D_MODEL // HEAD_DIM
N_KV_HEADS = N_HEADS // 4
GROUP = N_HEADS // N_KV_HEADS
WINDOW = 128
BLOCK = 128
ROPE_BASE = 10000.0
CONV_WIDTH = 3
D_FF = 4 * D_MODEL
N_MOD = 6
EPS = 1e-6
NEG = -1e30
N_CONV_LAYERS = (DEPTH + 1) // 2
N_ATTN_LAYERS = DEPTH // 2

kernel_name = "hybrid_shortconv_swa_dit_block"


def _rmsnorm(x, g):
    x32 = x.astype(jnp.float32)
    y = x32 * lax.rsqrt(jnp.mean(x32 * x32, axis=-1, keepdims=True) + EPS)
    return y.astype(x.dtype) * g


def _axial_rope_tables(seq_len):
    rows_n = seq_len // GRID_W
    row = jnp.repeat(jnp.arange(rows_n), GRID_W).astype(jnp.float32)
    col = jnp.tile(jnp.arange(GRID_W), rows_n).astype(jnp.float32)
    nf = HEAD_DIM // 4
    inv_freq = ROPE_BASE ** (-jnp.arange(nf, dtype=jnp.float32) / nf)
    ang_r = row[:, None] * inv_freq[None, :]
    ang_c = col[:, None] * inv_freq[None, :]
    ang = jnp.concatenate([ang_r, ang_r, ang_c, ang_c], axis=-1)
    return jnp.cos(ang), jnp.sin(ang)


def _rotate_half_axial(x):
    shp = x.shape
    xr = x.reshape(shp[:-1] + (2, 2, HEAD_DIM // 4))
    rot = jnp.stack([-xr[..., 1, :], xr[..., 0, :]], axis=-2)
    return rot.reshape(shp)


def _apply_rope(x, cos, sin):
    return x * cos.astype(x.dtype) + _rotate_half_axial(x) * sin.astype(x.dtype)


def _short_conv_mixer(u, w_in, w_conv, w_out):
    b_gate, c_gate, hval = jnp.split(u @ w_in, 3, axis=-1)
    z = c_gate * hval
    zp = jnp.pad(z, ((0, 0), (1, 1), (0, 0)))
    conv = zp[:, :-2] * w_conv[0] + zp[:, 1:-1] * w_conv[1] + zp[:, 2:] * w_conv[2]
    return (b_gate * conv) @ w_out


def _split_qkv(t):
    b, n, _ = t.shape
    q, k, v = jnp.split(t, [N_HEADS * HEAD_DIM, (N_HEADS + N_KV_HEADS) * HEAD_DIM], axis=-1)
    return (q.reshape(b, n, N_KV_HEADS, GROUP, HEAD_DIM),
            k.reshape(b, n, N_KV_HEADS, HEAD_DIM),
            v.reshape(b, n, N_KV_HEADS, HEAD_DIM))


def _window_attention(u, uc, w_qkv, sink, w_o, ctx_out):
    b, s, _ = u.shape
    scale = 1.0 / math.sqrt(HEAD_DIM)
    q, k, v = _split_qkv(u @ w_qkv)
    qc, kc, vc = _split_qkv(uc @ w_qkv)
    cos, sin = _axial_rope_tables(s)
    q = _apply_rope(q, cos[:, None, None, :], sin[:, None, None, :])
    k = _apply_rope(k, cos[:, None, :], sin[:, None, :])

    nb = s // BLOCK
    qb = q.reshape(b, nb, BLOCK, N_KV_HEADS, GROUP, HEAD_DIM)
    pad = ((0, 0), (BLOCK, BLOCK), (0, 0), (0, 0))
    kp = jnp.pad(k, pad).reshape(b, nb + 2, BLOCK, N_KV_HEADS, HEAD_DIM)
    vp = jnp.pad(v, pad).reshape(b, nb + 2, BLOCK, N_KV_HEADS, HEAD_DIM)
    kw = jnp.concatenate([kp[:, :-2], kp[:, 1:-1], kp[:, 2:]], axis=2)
    vw = jnp.concatenate([vp[:, :-2], vp[:, 1:-1], vp[:, 2:]], axis=2)

    blk = jnp.arange(nb)[:, None, None] * BLOCK
    qi = blk + jnp.arange(BLOCK)[None, :, None]
    kj = blk - BLOCK + jnp.arange(3 * BLOCK)[None, None, :]
    valid = (jnp.abs(qi - kj) <= WINDOW) & (kj >= 0) & (kj < s)

    s_loc = jnp.einsum('bnqhgd,bnkhd->bnhgqk', qb, kw).astype(jnp.float32) * scale
    s_loc = jnp.where(valid[None, :, None, None], s_loc, NEG)
    s_ctx = jnp.einsum('bnqhgd,bchd->bnhgqc', qb, kc).astype(jnp.float32) * scale
    sink_h = sink.astype(jnp.float32).reshape(N_KV_HEADS, GROUP)
    s_sink = jnp.broadcast_to(sink_h[None, None, :, :, None, None], s_loc.shape[:-1] + (1,))
    p = jax.nn.softmax(jnp.concatenate([s_loc, s_ctx, s_sink], axis=-1), axis=-1)
    n_loc = 3 * BLOCK
    n_ctx = kc.shape[1]
    p_loc = p[..., :n_loc].astype(v.dtype)
    p_ctx = p[..., n_loc:n_loc + n_ctx].astype(v.dtype)
    o = (jnp.einsum('bnhgqk,bnkhd->bnqhgd', p_loc, vw)
         + jnp.einsum('bnhgqc,bchd->bnqhgd', p_ctx, vc))
    y = o.reshape(b, s, N_HEADS * HEAD_DIM) @ w_o

    yc = None
    if ctx_out:
        sc = jnp.einsum('bqhgd,bkhd->bhgqk', qc, kc).astype(jnp.float32) * scale
        sc_sink = jnp.broadcast_to(sink_h[None, :, :, None, None], sc.shape[:-1] + (1,))
        pc = jax.nn.softmax(jnp.concatenate([sc, sc_sink], axis=-1), axis=-1)[..., :n_ctx]
        oc = jnp.einsum('bhgqk,bkhd->bqhgd', pc.astype(vc.dtype), vc)
        yc = oc.reshape(b, n_ctx, N_HEADS * HEAD_DIM) @ w_o
    return y, yc


def _sq_relu_mlp(u, w1, w2):
    return jnp.square(jax.nn.relu(u @ w1)) @ w2


def setup_inputs(seed: int = 0) -> dict:
    key = jax.random.key(seed)
    ks = jax.random.split(key, 20)
    d = D_MODEL
    qkv_w = (N_HEADS + 2 * N_KV_HEADS) * HEAD_DIM

    def nrm(k, shape, scale):
        return jax.random.normal(k, shape, jnp.float32) * scale

    return {
        "x": nrm(ks[0], (BATCH, SEQ, d), 1.0),
        "c": nrm(ks[1], (BATCH, d), 1.0),
        "ctx": nrm(ks[2], (BATCH, CTX_LEN, d), 1.0),
        "c_ctx": nrm(ks[3], (d,), 1.0),
        "norm1_g": 1.0 + nrm(ks[4], (DEPTH, d), 0.02),
        "norm2_g": 1.0 + nrm(ks[5], (DEPTH, d), 0.02),
        "mod_w": nrm(ks[6], (DEPTH, d, N_MOD * d), 0.5 * d ** -0.5),
        "mod_b": nrm(ks[7], (DEPTH, N_MOD * d), 0.02),
        "conv_w_in": nrm(ks[8], (N_CONV_LAYERS, d, 3 * d), d ** -0.5),
        "conv_w": nrm(ks[9], (N_CONV_LAYERS, CONV_WIDTH, d), CONV_WIDTH ** -0.5),
        "conv_w_out": nrm(ks[10], (N_CONV_LAYERS, d, d), d ** -0.5),
        "attn_w_qkv": nrm(ks[11], (N_ATTN_LAYERS, d, qkv_w), d ** -0.5),
        "attn_sink": nrm(ks[12], (N_ATTN_LAYERS, N_HEADS), 0.5),
        "attn_w_o": nrm(ks[13], (N_ATTN_LAYERS, N_HEADS * HEAD_DIM, d), (N_HEADS * HEAD_DIM) ** -0.5),
        "mlp_w1": nrm(ks[14], (DEPTH, d, D_FF), d ** -0.5),
        "mlp_w2": nrm(ks[15], (DEPTH, D_FF, d), D_FF ** -0.5),
        "final_g": 1.0 + nrm(ks[16], (d,), 0.02),
    }


def reference(x, c, ctx, c_ctx, norm1_g, norm2_g, mod_w, mod_b, conv_w_in, conv_w, conv_w_out,
              attn_w_qkv, attn_sink, attn_w_o, mlp_w1, mlp_w2, final_g):
    h = x
    hc = ctx
    sc_lat = jax.nn.silu(c)
    sc_ctx = jax.nn.silu(c_ctx)
    for i in range(DEPTH):
        last = i == DEPTH - 1
        m = sc_lat @ mod_w[i] + mod_b[i]
        mc = sc_ctx @ mod_w[i] + mod_b[i]
        sh1, s1, g1, sh2, s2, g2 = jnp.split(m[:, None, :], N_MOD, axis=-1)
        csh1, cs1, cg1, csh2, cs2, cg2 = jnp.split(mc, N_MOD, axis=-1)

        u = _rmsnorm(h, norm1_g[i]) * (1.0 + s1) + sh1
        if i % N_MIXERS == 0:
            j = i // N_MIXERS
            y = _short_conv_mixer(u, conv_w_in[j], conv_w[j], conv_w_out[j])
            if not last:
                uc = _rmsnorm(hc, norm1_g[i]) * (1.0 + cs1) + csh1
                yc = _short_conv_mixer(uc, conv_w_in[j], conv_w[j], conv_w_out[j])
        else:
            j = i // N_MIXERS
            uc = _rmsnorm(hc, norm1_g[i]) * (1.0 + cs1) + csh1
            y, yc = _window_attention(u, uc, attn_w_qkv[j], attn_sink[j], attn_w_o[j], not last)
        h = h + g1 * y

        u2 = _rmsnorm(h, norm2_g[i]) * (1.0 + s2) + sh2
        h = h + g2 * _sq_relu_mlp(u2, mlp_w1[i], mlp_w2[i])
        if not last:
            hc = hc + cg1 * yc
            uc2 = _rmsnorm(hc, norm2_g[i]) * (1.0 + cs2) + csh2
            hc = hc + cg2 * _sq_relu_mlp(uc2, mlp_w1[i], mlp_w2[i])
    return _rmsnorm(h, final_g)
```

```cpp
#include <hip/hip_runtime.h>
#include <hip/hip_cooperative_groups.h>
#include <cstdio>
#include <cstdint>
namespace cg = cooperative_groups;

#ifndef MK_N_LAUNCHES
#define MK_N_LAUNCHES 1
#endif

constexpr int D = 2048, BATCH = 8, SEQ = 2048, CTXL = 256, FF = 8192, NMOD = 6 * D;
constexpr int ML = BATCH * SEQ, MC = BATCH * CTXL, MT = ML + MC;
constexpr int NQK = 2560;
constexpr float EPS = 1e-6f;
constexpr float LOG2E = 1.4426950408889634f;
constexpr float QSCALE = 0.08838834764831845f * LOG2E;

namespace pg8 {
#define PG8_LAS __attribute__((address_space(3)))
typedef unsigned short bf16_t;
typedef short bf16x8 __attribute__((ext_vector_type(8)));
typedef float f32x4 __attribute__((ext_vector_type(4)));
typedef unsigned u32x4 __attribute__((ext_vector_type(4)));
constexpr int BM = 256, BK = 64, HALF = 128, HTB = HALF * BK * 2, STAGE_BYTES = 8 * HTB, NXCD = 8, WGM = 8;

__host__ __device__ __forceinline__ int lds_byte(int r, int c) { const int st = (r >> 4) * 2 + (c >> 5), rr = r & 15, cc = c & 31, ob = rr * 64 + cc * 2; return st * 1024 + (ob ^ (((ob >> 9) & 1) << 5)); }
__host__ __device__ __forceinline__ void stage_rc(int b, int& R, int& C) { const int st = b / 1024, sb = b % 1024, swz = sb ^ (((sb >> 9) & 1) << 5); R = (st >> 1) * 16 + swz / 64; C = (st & 1) * 32 + (swz % 64) / 2; }
__host__ __device__ __forceinline__ int perm32(int rho) { const int n = rho >> 4, i = rho & 15; return 8 * (i >> 2) + 4 * n + (i & 3); }

struct Unit { int pm, pn, kind, k0, nt; };
struct Gemm { const bf16_t* A; const bf16_t* Bt; const bf16_t* A2; const bf16_t* Bt2; int K; };

struct StaticOrder {
    int nM, nN, nwg, G, c, ntk;
    __host__ __device__ void init(int M, int N, int K, int G_, int c_) { nM = M / BM; nN = N / BM; nwg = nM * nN; G = G_; c = c_; ntk = K / BK; }
    __host__ __device__ bool map(long L, Unit& u) const {
        if (L >= nwg) return false;
        int wgid = (int)L; { const int q = nwg / NXCD, r = nwg % NXCD, xcd = wgid % NXCD, off = wgid / NXCD; wgid = (xcd < r ? xcd * (q + 1) : r * (q + 1) + (xcd - r) * q) + off; }
        const int nig = WGM * nN, gid = wgid / nig, fm = gid * WGM, gsz = (nM - fm) < WGM ? (nM - fm) : WGM;
        u.pm = fm + ((wgid % nig) % gsz); u.pn = (wgid % nig) / gsz; u.kind = 0; u.k0 = 0; u.nt = ntk; return true;
    }
    __host__ __device__ bool next(int i, Unit& u) const { return map((long)i * G + c, u); }
};
struct QkvOrder {
    StaticOrder so; int nvt;
    __host__ __device__ void init(int G_, int c_) { so.init(MT, NQK, D, G_, c_); nvt = 2 * (MT / BM); }
    __host__ __device__ bool next(int i, Unit& u) const {
        const long L = (long)i * so.G + so.c;
        if (L < so.nwg) return so.map(L, u);
        const int r = (int)(L - so.nwg); if (r >= nvt) return false;
        u.pm = r / (MT / BM); u.pn = r % (MT / BM); u.kind = 1; u.k0 = 0; u.nt = so.ntk; return true;
    }
};
struct QuarterOrder {
    int G, c, ntq;
    __host__ __device__ void init(int K, int G_, int c_) { G = G_; c = c_; ntq = K / BK / 4; }
    __host__ __device__ bool next(int i, Unit& u) const {
        const int r = i * G + c; if (r >= 256) return false;
        u.pm = ML / BM + ((r & 63) >> 3); u.pn = r & 7; u.kind = 0; u.nt = ntq; u.k0 = (r >> 6) * ntq * BK; return true;
    }
};

__device__ __forceinline__ unsigned cvt_pk_bf16(float lo, float hi) { unsigned r; asm volatile("v_cvt_pk_bf16_f32 %0, %1, %2" : "=v"(r) : "v"(lo), "v"(hi)); return r; }


struct EpiConvIn {
    static constexpr bool PERM = true;
    bf16_t* Bb; bf16_t* Zb;
    __device__ __forceinline__ void operator()(const f32x4 (&acc)[2][2][4][2], const Unit& u, int wr, int wc, int fr, int fq) const {
        const int row0 = u.pm * BM + wr * 64 + fr;
        if (u.pn < 8) {
            const int col0 = u.pn * BM + wc * 32 + 8 * fq;
#pragma unroll
            for (int ai = 0; ai < 2; ++ai)
#pragma unroll
                for (int m = 0; m < 4; ++m) { bf16_t* rowp = Bb + (size_t)(row0 + ai * HALF + m * 16) * D + col0;
#pragma unroll
                    for (int bj = 0; bj < 2; ++bj) { const f32x4 v0 = acc[ai][bj][m][0], v1 = acc[ai][bj][m][1];
                        u32x4 w; w.x = cvt_pk_bf16(v0[0], v0[1]); w.y = cvt_pk_bf16(v0[2], v0[3]); w.z = cvt_pk_bf16(v1[0], v1[1]); w.w = cvt_pk_bf16(v1[2], v1[3]);
                        *(u32x4*)(rowp + bj * HALF) = w; } }
        } else {
            const int col0 = (u.pn - 8) * HALF + wc * 32 + 8 * fq;
#pragma unroll
            for (int ai = 0; ai < 2; ++ai)
#pragma unroll
                for (int m = 0; m < 4; ++m) { bf16_t* rowp = Zb + (size_t)(row0 + ai * HALF + m * 16) * D + col0;
                    const f32x4 v0 = acc[ai][0][m][0] * acc[ai][1][m][0], v1 = acc[ai][0][m][1] * acc[ai][1][m][1];
                    u32x4 w; w.x = cvt_pk_bf16(v0[0], v0[1]); w.y = cvt_pk_bf16(v0[2], v0[3]); w.z = cvt_pk_bf16(v1[0], v1[1]); w.w = cvt_pk_bf16(v1[2], v1[3]);
                    *(u32x4*)rowp = w; }
        }
    }
};
struct EpiRelu2 {
    static constexpr bool PERM = true;
    bf16_t* O; const float* rstd; const float* shw;
    __device__ __forceinline__ void operator()(const f32x4 (&acc)[2][2][4][2], const Unit& u, int wr, int wc, int fr, int fq) const {
        const int row0 = u.pm * BM + wr * 64 + fr, col0 = u.pn * BM + wc * 32 + 8 * fq;
        const int mr = u.pm < (ML / BM) ? u.pm / (SEQ / BM) : BATCH;
        f32x4 bv[2][2];
#pragma unroll
        for (int bj = 0; bj < 2; ++bj)
#pragma unroll
            for (int n = 0; n < 2; ++n) bv[bj][n] = *(const f32x4*)(shw + (size_t)mr * FF + col0 + bj * HALF + 4 * n);
#pragma unroll
        for (int ai = 0; ai < 2; ++ai)
#pragma unroll
            for (int m = 0; m < 4; ++m) { const int row = row0 + ai * HALF + m * 16; bf16_t* rowp = O + (size_t)row * FF + col0; const float rs = rstd[row];
#pragma unroll
                for (int bj = 0; bj < 2; ++bj) { f32x4 v0 = acc[ai][bj][m][0] * rs + bv[bj][0], v1 = acc[ai][bj][m][1] * rs + bv[bj][1];
#pragma unroll
                    for (int e = 0; e < 4; ++e) { const float a = fmaxf(v0[e], 0.f), b = fmaxf(v1[e], 0.f); v0[e] = a * a; v1[e] = b * b; }
                    u32x4 w; w.x = cvt_pk_bf16(v0[0], v0[1]); w.y = cvt_pk_bf16(v0[2], v0[3]); w.z = cvt_pk_bf16(v1[0], v1[1]); w.w = cvt_pk_bf16(v1[2], v1[3]);
                    *(u32x4*)(rowp + bj * HALF) = w; } }
    }
};
template <bool NP, bool BASE_BF16> struct EpiResid {
    static constexpr bool PERM = true;
    const void* base; bf16_t* Hb; const float* gate;
    const float* ng; const float* ns; bf16_t* U; float* ssp;
    __device__ __forceinline__ void operator()(const f32x4 (&acc)[2][2][4][2], const Unit& u, int wr, int wc, int fr, int fq) const {
        const int col0 = u.pn * BM + wc * 32 + 8 * fq;
        const int mr = u.pm / (SEQ / BM);
        const float* gp = gate + (size_t)mr * NMOD + col0;
        float ss[2][4];
#pragma unroll
        for (int ai = 0; ai < 2; ++ai)
#pragma unroll
            for (int m = 0; m < 4; ++m) ss[ai][m] = 0.f;
#pragma unroll
        for (int bj = 0; bj < 2; ++bj) {
            f32x4 gv[2], gs[2];
#pragma unroll
            for (int n = 0; n < 2; ++n) { gv[n] = *(const f32x4*)(gp + bj * HALF + 4 * n);
                if constexpr (NP) gs[n] = *(const f32x4*)(ng + col0 + bj * HALF + 4 * n) * (*(const f32x4*)(ns + (size_t)mr * NMOD + col0 + bj * HALF + 4 * n) + 1.f); }
#pragma unroll
            for (int ai = 0; ai < 2; ++ai)
#pragma unroll
                for (int m = 0; m < 4; ++m) { const size_t off = (size_t)(u.pm * BM + ai * HALF + wr * 64 + m * 16 + fr) * D + col0 + bj * HALF;
                    f32x4 b0, b1;
                    if constexpr (BASE_BF16) { const u32x4 w = *(const u32x4*)((const bf16_t*)base + off);
                        b0 = (f32x4){__uint_as_float(w.x << 16), __uint_as_float(w.x & 0xffff0000u), __uint_as_float(w.y << 16), __uint_as_float(w.y & 0xffff0000u)};
                        b1 = (f32x4){__uint_as_float(w.z << 16), __uint_as_float(w.z & 0xffff0000u), __uint_as_float(w.w << 16), __uint_as_float(w.w & 0xffff0000u)}; }
                    else { b0 = *(const f32x4*)((const float*)base + off); b1 = *(const f32x4*)((const float*)base + off + 4); }
                    const f32x4 h0 = b0 + gv[0] * acc[ai][bj][m][0], h1 = b1 + gv[1] * acc[ai][bj][m][1];
                    u32x4 hw; hw.x = cvt_pk_bf16(h0[0], h0[1]); hw.y = cvt_pk_bf16(h0[2], h0[3]); hw.z = cvt_pk_bf16(h1[0], h1[1]); hw.w = cvt_pk_bf16(h1[2], h1[3]);
                    *(u32x4*)(Hb + off) = hw;
                    if constexpr (NP) { ss[ai][m] += ((h0[0] * h0[0] + h0[1] * h0[1]) + (h0[2] * h0[2] + h0[3] * h0[3])) + ((h1[0] * h1[0] + h1[1] * h1[1]) + (h1[2] * h1[2] + h1[3] * h1[3]));
                        const f32x4 t0 = h0 * gs[0], t1 = h1 * gs[1];
                        u32x4 uw; uw.x = cvt_pk_bf16(t0[0], t0[1]); uw.y = cvt_pk_bf16(t0[2], t0[3]); uw.z = cvt_pk_bf16(t1[0], t1[1]); uw.w = cvt_pk_bf16(t1[2], t1[3]);
                        *(u32x4*)(U + off) = uw; } }
            asm volatile("" ::: "memory");
        }
        if constexpr (NP) {
#pragma unroll
            for (int ai = 0; ai < 2; ++ai)
#pragma unroll
                for (int m = 0; m < 4; ++m) { float t = ss[ai][m]; t += __shfl_xor(t, 16); t += __shfl_xor(t, 32);
                    if (fq == 0) ssp[(size_t)(u.pm * BM + ai * HALF + wr * 64 + m * 16 + fr) * 32 + u.pn * 4 + wc] = t; }
        }
    }
};
struct EpiPart {
    static constexpr bool PERM = false;
    float* part; int kq;
    __device__ __forceinline__ void operator()(const f32x4 (&acc)[2][2][4][2], const Unit& u, int wr, int wc, int fr, int fq) const {
        float* pp = part + ((size_t)(u.k0 / kq) * MC + (size_t)(u.pm - ML / BM) * BM) * D + u.pn * BM + wc * 32 + 4 * fq;
#pragma unroll
        for (int ai = 0; ai < 2; ++ai)
#pragma unroll
            for (int m = 0; m < 4; ++m) { const size_t off = (size_t)(ai * HALF + wr * 64 + m * 16 + fr) * D;
#pragma unroll
                for (int bj = 0; bj < 2; ++bj)
#pragma unroll
                    for (int n = 0; n < 2; ++n) *(f32x4*)(pp + off + bj * HALF + n * 16) = acc[ai][bj][m][n]; }
    }
};
struct EpiQkv {
    static constexpr bool PERM = true;
    bf16_t* QK; bf16_t* VT; const float* rstd; const float* shw;
    __device__ __forceinline__ void operator()(const f32x4 (&acc)[2][2][4][2], const Unit& u, int wr, int wc, int fr, int fq) const {
        const int row0 = u.pm * BM + wr * 64 + fr, col0 = u.pn * BM + wc * 32 + 8 * fq;
        if (u.kind == 1) {
            const int mrt = u.pn < (ML / BM) ? u.pn / (SEQ / BM) : BATCH;
            f32x4 rv[2][2];
#pragma unroll
            for (int bj = 0; bj < 2; ++bj)
#pragma unroll
                for (int n = 0; n < 2; ++n) rv[bj][n] = *(const f32x4*)(rstd + col0 + bj * HALF + 4 * n);
#pragma unroll
            for (int ai = 0; ai < 2; ++ai)
#pragma unroll
                for (int m = 0; m < 4; ++m) { const int drow = row0 + ai * HALF + m * 16; bf16_t* rowp = VT + (size_t)drow * MT + col0; const float bb = shw[(size_t)mrt * 3072 + NQK + drow];
#pragma unroll
                    for (int bj = 0; bj < 2; ++bj) { const f32x4 v0 = acc[ai][bj][m][0] * rv[bj][0] + bb, v1 = acc[ai][bj][m][1] * rv[bj][1] + bb;
                        u32x4 w; w.x = cvt_pk_bf16(v0[0], v0[1]); w.y = cvt_pk_bf16(v0[2], v0[3]); w.z = cvt_pk_bf16(v1[0], v1[1]); w.w = cvt_pk_bf16(v1[2], v1[3]);
                        *(u32x4*)(rowp + bj * HALF) = w; } }
            return;
        }
        const bool lat = u.pm < (ML / BM);
        const float sc = u.pn < 8 ? QSCALE : 1.f;
        const int mrq = lat ? u.pm / (SEQ / BM) : BATCH;
        f32x4 bq[2][2];
#pragma unroll
        for (int bj = 0; bj < 2; ++bj)
#pragma unroll
            for (int n = 0; n < 2; ++n) bq[bj][n] = *(const f32x4*)(shw + (size_t)mrq * 3072 + col0 + bj * HALF + 4 * n);
        float invf[2][2];
#pragma unroll
        for (int n = 0; n < 2; ++n)
#pragma unroll
            for (int j = 0; j < 2; ++j) { const int f = 16 * (wc & 1) + 4 * fq + 2 * n + j; invf[n][j] = exp2f(-(float)f * (13.287712379549449f / 32.f)); }
#pragma unroll
        for (int ai = 0; ai < 2; ++ai)
#pragma unroll
            for (int m = 0; m < 4; ++m) {
                const int row = row0 + ai * HALF + m * 16; const int s = row & (SEQ - 1);
                const float pos = (float)((wc >> 1) ? (s & 63) : (s >> 6));
                float cs[2][2], sn[2][2];
#pragma unroll
                for (int n = 0; n < 2; ++n)
#pragma unroll
                    for (int j = 0; j < 2; ++j) { const float ang = pos * invf[n][j]; cs[n][j] = lat ? __cosf(ang) : 1.f; sn[n][j] = lat ? __sinf(ang) : 0.f; }
                bf16_t* rowp = QK + (size_t)row * NQK + col0; const float rs = rstd[row];
#pragma unroll
                for (int bj = 0; bj < 2; ++bj) { f32x4 v[2] = {acc[ai][bj][m][0] * rs + bq[bj][0], acc[ai][bj][m][1] * rs + bq[bj][1]};
#pragma unroll
                    for (int n = 0; n < 2; ++n)
#pragma unroll
                        for (int j = 0; j < 2; ++j) { const float x0 = v[n][2 * j], x1 = v[n][2 * j + 1];
                            v[n][2 * j] = (x0 * cs[n][j] - x1 * sn[n][j]) * sc; v[n][2 * j + 1] = (x1 * cs[n][j] + x0 * sn[n][j]) * sc; }
                    u32x4 w; w.x = cvt_pk_bf16(v[0][0], v[0][1]); w.y = cvt_pk_bf16(v[0][2], v[0][3]); w.z = cvt_pk_bf16(v[1][0], v[1][1]); w.w = cvt_pk_bf16(v[1][2], v[1][3]);
                    *(u32x4*)(rowp + bj * HALF) = w; }
            }
    }
};

template <class Epi, class Sched, bool ALIGN_EPI = false, bool SP2 = false>
__device__ __forceinline__ void gemm_phase(PG8_LAS unsigned char* lds, const Gemm g, const Sched& S, const Epi& E) {
    const int tid = threadIdx.x, wid = __builtin_amdgcn_readfirstlane(tid >> 6), lane = tid & 63, wr = wid >> 2, wc = wid & 3, fr = lane & 15, fq = lane >> 4;
    const int K = g.K;
    unsigned voffA[2], voffB[2];
#pragma unroll
    for (int i = 0; i < 2; ++i) { int R, C; stage_rc(tid * 16 + i * 8192, R, C); const int Rb = Epi::PERM ? ((R & ~31) + perm32(R & 31)) : R;
        voffA[i] = (unsigned)(R * K + C) * 2u; voffB[i] = (unsigned)(Rb * K + C) * 2u; }
    const size_t kstep = (size_t)(BK * 2);
    const size_t hstep = (size_t)HALF * K * 2;
    const size_t tstep = 2 * hstep;
    const unsigned ldsw = (unsigned)wid * 1024u;
    const int aoff = lds_byte(wr * 64 + fr, fq * 8), boff = lds_byte(wc * 32 + fr, fq * 8);
#define PG8_SA(b, h) (((b) * 2 + (h)) * HTB)
#define PG8_SB(b, h) ((4 + (b) * 2 + (h)) * HTB)
#define PG8_STAGE(bufoff, gbase, voff) do { _Pragma("unroll") for (int _i = 0; _i < 2; ++_i) \
        __builtin_amdgcn_global_load_lds((const unsigned*)((const char*)(gbase) + (voff)[_i]), (PG8_LAS unsigned*)(lds + (bufoff) + ldsw + _i * 8192), 16, 0, 0); } while (0)
#define PG8_LDA(dst, b, h) do { _Pragma("unroll") for (int m = 0; m < 4; ++m) _Pragma("unroll") for (int k = 0; k < 2; ++k) dst[m][k] = *(const PG8_LAS bf16x8*)(lds + PG8_SA(b, h) + aoff + m * 2048 + k * 1024); } while (0)
#define PG8_LDB(dst, b, h) do { _Pragma("unroll") for (int n = 0; n < 2; ++n) _Pragma("unroll") for (int k = 0; k < 2; ++k) dst[n][k] = *(const PG8_LAS bf16x8*)(lds + PG8_SB(b, h) + boff + n * 2048 + k * 1024); } while (0)
#define PG8_MMA(ai, bj, At, Bt) do { __builtin_amdgcn_s_setprio(1); _Pragma("unroll") for (int m = 0; m < 4; ++m) _Pragma("unroll") for (int n = 0; n < 2; ++n) _Pragma("unroll") for (int k = 0; k < 2; ++k) \
        acc[ai][bj][m][n] = __builtin_amdgcn_mfma_f32_16x16x32_bf16(Bt[n][k], At[m][k], acc[ai][bj][m][n], 0, 0, 0); __builtin_amdgcn_s_setprio(0); } while (0)
#define PG8_WAIT_V(n) asm volatile("s_waitcnt vmcnt(" #n ")" ::: "memory")
#define PG8_WAIT_L(n) asm volatile("s_waitcnt lgkmcnt(" #n ")" ::: "memory")
#define PG8_BAR __builtin_amdgcn_s_barrier()
#define PG8_SCHED __builtin_amdgcn_sched_barrier(0)
#define PG8_UA(u) ((const char*)((u).kind ? g.A2 : g.A) + (size_t)(u).pm * tstep + (size_t)(u).k0 * 2)
#define PG8_UB(u) ((const char*)((u).kind ? g.Bt2 : g.Bt) + (size_t)(u).pn * tstep + (size_t)(u).k0 * 2)
    Unit cur, nxt; int ui = 0;
    if (!S.next(0, cur)) return;
    f32x4 acc[2][2][4][2];
#pragma unroll
    for (int a = 0; a < 2; ++a)
#pragma unroll
        for (int b = 0; b < 2; ++b)
#pragma unroll
            for (int m = 0; m < 4; ++m)
#pragma unroll
                for (int n = 0; n < 2; ++n) acc[a][b][m][n] = (f32x4){0.f, 0.f, 0.f, 0.f};
    bf16x8 At[4][2], B0[2][2], B1[2][2];
    const char* cA = PG8_UA(cur); const char* cB = PG8_UB(cur);
    if constexpr (SP2) {
        PG8_STAGE(PG8_SB(0, 0), cB, voffB); PG8_STAGE(PG8_SB(0, 1), cB + hstep, voffB); PG8_STAGE(PG8_SA(0, 0), cA, voffA); PG8_STAGE(PG8_SA(0, 1), cA + hstep, voffA);
        if (wr == 1) PG8_BAR;
        PG8_WAIT_V(2); PG8_BAR;
        PG8_STAGE(PG8_SB(1, 0), cB + kstep, voffB); PG8_STAGE(PG8_SA(1, 0), cA + kstep, voffA); PG8_STAGE(PG8_SB(1, 1), cB + hstep + kstep, voffB);
        PG8_WAIT_V(6); PG8_BAR;
    } else {
        PG8_STAGE(PG8_SB(0, 0), cB, voffB); PG8_STAGE(PG8_SA(0, 0), cA, voffA); PG8_STAGE(PG8_SB(0, 1), cB + hstep, voffB); PG8_STAGE(PG8_SA(0, 1), cA + hstep, voffA);
        if (wr == 1) PG8_BAR;
        PG8_WAIT_V(4); PG8_BAR;
        PG8_STAGE(PG8_SB(1, 0), cB + kstep, voffB); PG8_STAGE(PG8_SA(1, 0), cA + kstep, voffA); PG8_STAGE(PG8_SB(1, 1), cB + hstep + kstep, voffB);
        PG8_WAIT_V(6); PG8_BAR;
    }
    for (;;) {
        const bool has_next = S.next(ui + 1, nxt);
        const char* nA = has_next ? PG8_UA(nxt) : cA; const char* nB = has_next ? PG8_UB(nxt) : cB;
        const int nt = cur.nt;
        for (int t = 0; t < nt; t += 2) {
            const bool last = (t == nt - 2);
            const char* a1 = cA + (size_t)(t + 1) * kstep;
            const char* a2 = last ? nA : cA + (size_t)(t + 2) * kstep; const char* b2 = last ? nB : cB + (size_t)(t + 2) * kstep;
            const char* a3 = a2 + kstep; const char* b3 = b2 + kstep;
            if constexpr (SP2) {
            PG8_LDB(B0, 0, 0); PG8_LDB(B1, 0, 1); PG8_SCHED; PG8_LDA(At, 0, 0); PG8_STAGE(PG8_SA(1, 1), a1 + hstep, voffA);
            PG8_WAIT_V(8); PG8_WAIT_L(0); PG8_BAR; PG8_MMA(0, 0, At, B0); PG8_MMA(0, 1, At, B1); PG8_BAR; PG8_SCHED;
            PG8_LDA(At, 0, 1); PG8_STAGE(PG8_SB(0, 0), b2, voffB); PG8_STAGE(PG8_SB(0, 1), b2 + hstep, voffB); PG8_STAGE(PG8_SA(0, 0), a2, voffA);
            PG8_WAIT_V(8); PG8_WAIT_L(0); PG8_BAR; PG8_MMA(1, 0, At, B0); PG8_MMA(1, 1, At, B1); PG8_BAR; PG8_SCHED;
            PG8_LDB(B0, 1, 0); PG8_LDB(B1, 1, 1); PG8_SCHED; PG8_LDA(At, 1, 0); PG8_STAGE(PG8_SA(0, 1), a2 + hstep, voffA);
            PG8_WAIT_V(8); PG8_WAIT_L(0); PG8_BAR; PG8_MMA(0, 0, At, B0); PG8_MMA(0, 1, At, B1); PG8_BAR; PG8_SCHED;
            PG8_LDA(At, 1, 1); PG8_STAGE(PG8_SB(1, 0), b3, voffB); PG8_STAGE(PG8_SB(1, 1), b3 + hstep, voffB); PG8_STAGE(PG8_SA(1, 0), a3, voffA);
            PG8_WAIT_V(8); PG8_WAIT_L(0); PG8_BAR; PG8_MMA(1, 0, At, B0); PG8_MMA(1, 1, At, B1); PG8_BAR; PG8_SCHED;
            } else {
            PG8_LDB(B0, 0, 0); PG8_SCHED; PG8_LDA(At, 0, 0); PG8_STAGE(PG8_SA(1, 1), a1 + hstep, voffA);
            PG8_WAIT_L(8); PG8_BAR; PG8_WAIT_L(0); PG8_MMA(0, 0, At, B0); PG8_BAR; PG8_SCHED;
            PG8_LDB(B1, 0, 1); PG8_STAGE(PG8_SB(0, 0), b2, voffB);
            PG8_BAR; PG8_WAIT_L(0); PG8_MMA(0, 1, At, B1); PG8_BAR;
            PG8_LDA(At, 0, 1); PG8_STAGE(PG8_SA(0, 0), a2, voffA);
            PG8_BAR; PG8_WAIT_L(0); PG8_MMA(1, 0, At, B0); PG8_BAR; PG8_SCHED;
            PG8_STAGE(PG8_SB(0, 1), b2 + hstep, voffB);
            PG8_WAIT_V(6); PG8_BAR; PG8_MMA(1, 1, At, B1); PG8_BAR;
            PG8_LDB(B0, 1, 0); PG8_SCHED; PG8_LDA(At, 1, 0); PG8_STAGE(PG8_SA(0, 1), a2 + hstep, voffA);
            PG8_WAIT_L(8); PG8_BAR; PG8_WAIT_L(0); PG8_MMA(0, 0, At, B0); PG8_BAR; PG8_SCHED;
            PG8_LDB(B1, 1, 1); PG8_STAGE(PG8_SB(1, 0), b3, voffB);
            PG8_BAR; PG8_WAIT_L(0); PG8_MMA(0, 1, At, B1); PG8_BAR;
            PG8_LDA(At, 1, 1); PG8_STAGE(PG8_SA(1, 0), a3, voffA);
            PG8_BAR; PG8_WAIT_L(0); PG8_MMA(1, 0, At, B0); PG8_BAR; PG8_SCHED;
            PG8_STAGE(PG8_SB(1, 1), b3 + hstep, voffB);
            PG8_WAIT_V(6); PG8_BAR; PG8_MMA(1, 1, At, B1); PG8_BAR;
            }
        }
        if constexpr (ALIGN_EPI) { if (wr == 0) PG8_BAR; }
        E(acc, cur, wr, wc, fr, fq);
        if (!has_next) break;
#pragma unroll
        for (int a = 0; a < 2; ++a)
#pragma unroll
            for (int b = 0; b < 2; ++b)
#pragma unroll
                for (int m = 0; m < 4; ++m)
#pragma unroll
                    for (int n = 0; n < 2; ++n) acc[a][b][m][n] = (f32x4){0.f, 0.f, 0.f, 0.f};
        cur = nxt; cA = nA; cB = nB; ++ui;
        if constexpr (ALIGN_EPI) { if (wr == 1) PG8_BAR; }
    }
    PG8_WAIT_V(0);
    if constexpr (!ALIGN_EPI) { if (wr == 0) PG8_BAR; }
    PG8_BAR;
#undef PG8_SA
#undef PG8_SB
#undef PG8_STAGE
#undef PG8_LDA
#undef PG8_LDB
#undef PG8_MMA
#undef PG8_WAIT_V
#undef PG8_WAIT_L
#undef PG8_BAR
#undef PG8_SCHED
#undef PG8_UA
#undef PG8_UB
}
}

#define LAS __attribute__((address_space(3)))
typedef unsigned short bf16;
typedef unsigned v4u __attribute__((ext_vector_type(4)));
typedef unsigned v2u __attribute__((ext_vector_type(2)));
typedef float f32x4 __attribute__((ext_vector_type(4)));
typedef float f32x2 __attribute__((ext_vector_type(2)));
typedef float f32x16 __attribute__((ext_vector_type(16)));
typedef short bf16x8 __attribute__((ext_vector_type(8)));
constexpr int NWAVES = 8, NTHREADS = 512;
constexpr int RING_BYTES = 131072, LDS_BYTES = 147456;

__device__ __forceinline__ unsigned pk2(float lo, float hi) { return pg8::cvt_pk_bf16(lo, hi); }
__device__ __forceinline__ float bflo(unsigned w) { return __uint_as_float(w << 16); }
__device__ __forceinline__ float bfhi(unsigned w) { return __uint_as_float(w & 0xffff0000u); }
__device__ __forceinline__ float wave_sum(float v) {
#pragma unroll
    for (int o = 1; o < 64; o <<= 1) v += __shfl_xor(v, o);
    return v;
}

constexpr size_t MiB = 1u << 20;
constexpr size_t WS_MOD = 0;
constexpr size_t WS_WIN = 1 * MiB, WS_WOUT = 25 * MiB, WS_WQK = 33 * MiB, WS_WV = 43 * MiB, WS_WO = 45 * MiB, WS_W1 = 53 * MiB, WS_W2 = 117 * MiB;
constexpr size_t WS_U = 181 * MiB, WS_H = 253 * MiB, WS_R1 = 397 * MiB, WS_PART = 685 * MiB, WS_SSP = 749 * MiB, WS_RSTD = 751 * MiB, WS_SHW = 752 * MiB, WS_END = 753 * MiB;
constexpr size_t WS_BAR = 880 * 1024;
constexpr size_t R1_B = 0, R1_Z = 72 * MiB, R1_V = 144 * MiB;
constexpr size_t R1_QK = 0, R1_VT = 90 * MiB, R1_O = 108 * MiB;
constexpr size_t W1_STRIDE = (size_t)FF * D, W2_STRIDE = (size_t)D * FF;

struct Args { const float* in[17]; float* out; unsigned char* ws; int ph_lo, ph_hi; };

__device__ __forceinline__ void transpose_item(const float* W, int ldw, int K, int k0, int n0, bf16* WT, int dest_base, int dest_stride, LAS float* scr, int lane) {
    {
        f32x4 v[8]; const int kr = lane >> 3, c4 = (lane & 7) * 4;
#pragma unroll
        for (int i = 0; i < 8; ++i) v[i] = __builtin_nontemporal_load((const f32x4*)(W + (size_t)(k0 + 8 * i + kr) * ldw + n0 + c4));
#pragma unroll
        for (int i = 0; i < 8; ++i) { LAS float* d = scr + (8 * i + kr) * 33 + c4; d[0] = v[i].x; d[1] = v[i].y; d[2] = v[i].z; d[3] = v[i].w; }
    }
    asm volatile("s_waitcnt lgkmcnt(0)" ::: "memory");
    const int c = lane & 7;
#pragma unroll
    for (int j = 0; j < 4; ++j) { const int n = (lane >> 3) + 8 * j; const LAS float* s = scr + (8 * c) * 33 + n;
        v4u o; o.x = pk2(s[0 * 33], s[1 * 33]); o.y = pk2(s[2 * 33], s[3 * 33]); o.z = pk2(s[4 * 33], s[5 * 33]); o.w = pk2(s[6 * 33], s[7 * 33]);
        *(v4u*)(WT + (size_t)(dest_base + dest_stride * n) * K + k0 + 8 * c) = o; }
    asm volatile("s_waitcnt lgkmcnt(0)" ::: "memory");
}

constexpr int I_IN = (D / 64) * (3 * D / 32), I_OUT = (D / 64) * (D / 32), I_QKV = (D / 64) * (3072 / 32), I_WO = I_OUT, I_W1 = (D / 64) * (FF / 32), I_W2 = (FF / 64) * (D / 32);
constexpr int TR_P0 = I_IN + I_QKV + I_W1 + I_W2, TR_T1 = TR_P0 + I_OUT + I_WO, TR_T2 = TR_T1 + I_W1 + I_W2;
__device__ __forceinline__ void transpose_dispatch(const Args& a, int r, LAS float* scr, int lane) {
    unsigned char* ws = a.ws;
    if (r < I_IN) { const int nblk = 3 * D / 32, kb = r / nblk, nb = r % nblk, n0 = 32 * nb; int dest;
        if (n0 < D) dest = n0; else if (n0 < 2 * D) { const int c = n0 - D; dest = D + 256 * (c >> 7) + (c & 127); } else { const int h = n0 - 2 * D; dest = D + 256 * (h >> 7) + 128 + (h & 127); }
        transpose_item(a.in[8], 3 * D, D, 64 * kb, n0, (bf16*)(ws + WS_WIN), dest, 1, scr, lane); return; } r -= I_IN;
    if (r < I_QKV) { const int nblk = 3072 / 32, kb = r / nblk, nb = r % nblk, n0 = 32 * nb;
        if (n0 < NQK) { const int hb = n0 & ~127, d0 = n0 & 127;
            transpose_item(a.in[11], 3072, D, 64 * kb, n0, (bf16*)(ws + WS_WQK), hb + 64 * (d0 >> 6) + ((d0 >> 5) & 1), 2, scr, lane); }
        else transpose_item(a.in[11], 3072, D, 64 * kb, n0, (bf16*)(ws + WS_WV), n0 - NQK, 1, scr, lane);
        return; } r -= I_QKV;
    if (r < I_W1) { const int nblk = FF / 32, kb = r / nblk, nb = r % nblk; transpose_item(a.in[14], FF, D, 64 * kb, 32 * nb, (bf16*)(ws + WS_W1), 32 * nb, 1, scr, lane); return; } r -= I_W1;
    if (r < I_W2) { const int nblk = D / 32, kb = r / nblk, nb = r % nblk; transpose_item(a.in[15], D, FF, 64 * kb, 32 * nb, (bf16*)(ws + WS_W2), 32 * nb, 1, scr, lane); return; } r -= I_W2;
    if (r < I_OUT) { const int nblk = D / 32, kb = r / nblk, nb = r % nblk; transpose_item(a.in[10], D, D, 64 * kb, 32 * nb, (bf16*)(ws + WS_WOUT), 32 * nb, 1, scr, lane); return; } r -= I_OUT;
    if (r < I_WO) { const int nblk = D / 32, kb = r / nblk, nb = r % nblk; transpose_item(a.in[13], D, D, 64 * kb, 32 * nb, (bf16*)(ws + WS_WO), 32 * nb, 1, scr, lane); return; } r -= I_WO;
    if (r < I_W1) { const int nblk = FF / 32, kb = r / nblk, nb = r % nblk; transpose_item(a.in[14] + (size_t)D * FF, FF, D, 64 * kb, 32 * nb, (bf16*)(ws + WS_W1) + W1_STRIDE, 32 * nb, 1, scr, lane); return; } r -= I_W1;
    { const int nblk = D / 32, kb = r / nblk, nb = r % nblk; transpose_item(a.in[15] + (size_t)FF * D, D, FF, 64 * kb, 32 * nb, (bf16*)(ws + WS_W2) + W2_STRIDE, 32 * nb, 1, scr, lane); }
}

__device__ __forceinline__ void p0_prologue(const Args& a, LAS unsigned char* lds) {
    const int tid = threadIdx.x, lane = tid & 63, wave = __builtin_amdgcn_readfirstlane(tid >> 6);
    const int G = gridDim.x;
    unsigned char* ws = a.ws;
    {
        LAS float* sc = (LAS float*)lds;
        LAS float* red = (LAS float*)(lds + 9 * D * 4);
        bool have = false;
        for (int t = blockIdx.x; t < 2 * (NMOD / 128); t += G) {
            if (!have) {
                for (int i = tid; i < 9 * D; i += NTHREADS) { const float v = i < 8 * D ? a.in[1][i] : a.in[3][i - 8 * D]; sc[i] = v / (1.f + __expf(-v)); }
                have = true;
            }
            __syncthreads();
            const int l = t / (NMOD / 128), cgp = t % (NMOD / 128);
            const float* w = a.in[6] + (size_t)l * D * NMOD + (size_t)(wave * 256) * NMOD + cgp * 128 + 2 * lane;
            float acc0[9], acc1[9];
#pragma unroll
            for (int r = 0; r < 9; ++r) { acc0[r] = 0.f; acc1[r] = 0.f; }
#pragma unroll 8
            for (int k = 0; k < 256; ++k) {
                const f32x2 wv = __builtin_nontemporal_load((const f32x2*)(w + (size_t)k * NMOD));
#pragma unroll
                for (int r = 0; r < 9; ++r) { const float s = sc[r * D + wave * 256 + k]; acc0[r] += s * wv.x; acc1[r] += s * wv.y; }
            }
#pragma unroll
            for (int r = 0; r < 9; ++r) { red[(wave * 9 + r) * 128 + 2 * lane] = acc0[r]; red[(wave * 9 + r) * 128 + 2 * lane + 1] = acc1[r]; }
            __syncthreads();
            for (int i = tid; i < 9 * 128; i += NTHREADS) { const int r = i >> 7, cc = i & 127; float s = 0.f;
#pragma unroll
                for (int w8 = 0; w8 < 8; ++w8) s += red[(w8 * 9 + r) * 128 + cc];
                ((float*)(ws + WS_MOD))[((size_t)l * 9 + r) * NMOD + cgp * 128 + cc] = s + a.in[7][(size_t)l * NMOD + cgp * 128 + cc]; }
        }
        __syncthreads();
    }
    LAS float* scr = (LAS float*)(lds + wave * 16384);
    const int ngemv = min(G, 2 * (NMOD / 128)), nfree = G - ngemv;
    constexpr int PRE = 4096;
    int pre = 0;
    if (nfree > 0) { pre = PRE; if ((int)blockIdx.x >= ngemv) for (int it = ((int)blockIdx.x - ngemv) * NWAVES + wave; it < PRE; it += nfree * NWAVES) transpose_dispatch(a, it, scr, lane); }
    for (int it = pre + blockIdx.x * NWAVES + wave; it < TR_P0; it += G * NWAVES) transpose_dispatch(a, it, scr, lane);
}
__device__ __forceinline__ void tail_transposes(const Args& a, LAS unsigned char* lds, int nunits, int lo, int hi) {
    const int lane = threadIdx.x & 63, wave = __builtin_amdgcn_readfirstlane(threadIdx.x >> 6), G = gridDim.x;
    const int first_idle = nunits % G, nidle = G - first_idle;
    if ((int)blockIdx.x < first_idle) return;
    LAS float* scr = (LAS float*)(lds + wave * 16384);
    for (int it = lo + ((int)blockIdx.x - first_idle) * NWAVES + wave; it < hi; it += nidle * NWAVES) transpose_dispatch(a, it, scr, lane);
}

__device__ __forceinline__ void norm_mod_phase(const float* lat, const float* ctx, int rbeg, int nrows, const float* g, const float* mod, int sh_idx, bf16* U,
                                               const float* part = nullptr, const float* pgate = nullptr, float* hctx_out = nullptr) {
    const int tid = threadIdx.x, lane = tid & 63, wave = __builtin_amdgcn_readfirstlane(tid >> 6);
    const int rpb = (nrows - rbeg + gridDim.x - 1) / gridDim.x, r0 = rbeg + blockIdx.x * rpb, r1 = min(nrows, r0 + rpb);
    f32x4 v[8], vn[8];
    { const int row = r0 + wave;
      if (row < r1) { const float* hr = row < ML ? lat + (size_t)row * D : ctx + (size_t)(row - ML) * D;
#pragma unroll
          for (int j = 0; j < 8; ++j) v[j] = __builtin_nontemporal_load((const f32x4*)(hr + 4 * lane + 256 * j)); } }
    for (int row = r0 + wave; row < r1; row += NWAVES) {
        const bool isc = row >= ML;
        const int mr = !isc ? row / SEQ : BATCH;
        const float* shp = mod + (size_t)mr * NMOD + (size_t)sh_idx * D; const float* sp = shp + D;
        float ss = 0.f;
        { const int nr = row + NWAVES;
          if (nr < r1) { const float* hn = nr < ML ? lat + (size_t)nr * D : ctx + (size_t)(nr - ML) * D;
#pragma unroll
              for (int j = 0; j < 8; ++j) vn[j] = __builtin_nontemporal_load((const f32x4*)(hn + 4 * lane + 256 * j)); } }
        if (isc && part) {
#pragma unroll
            for (int j = 0; j < 8; ++j) { const int c = 4 * lane + 256 * j; const float* pp = part + (size_t)(row - ML) * D + c;
                const f32x4 ps = (*(const f32x4*)pp + *(const f32x4*)(pp + (size_t)MC * D)) + (*(const f32x4*)(pp + (size_t)2 * MC * D) + *(const f32x4*)(pp + (size_t)3 * MC * D));
                v[j] = v[j] + *(const f32x4*)(pgate + c) * ps;
                if (hctx_out) *(f32x4*)(hctx_out + (size_t)(row - ML) * D + c) = v[j]; }
        }
#pragma unroll
        for (int j = 0; j < 8; ++j) ss += (v[j].x * v[j].x + v[j].y * v[j].y) + (v[j].z * v[j].z + v[j].w * v[j].w);
        const float rstd = rsqrtf(wave_sum(ss) * (1.f / D) + EPS);
#pragma unroll
        for (int j = 0; j < 8; ++j) { const int c = 4 * lane + 256 * j;
            const f32x4 gv = *(const f32x4*)(g + c), sv = *(const f32x4*)(sp + c), hv = *(const f32x4*)(shp + c);
            const f32x4 o = (v[j] * rstd) * gv * (sv + 1.f) + hv;
            v2u w; w.x = pk2(o.x, o.y); w.y = pk2(o.z, o.w); *(v2u*)(U + (size_t)row * D + c) = w; }
#pragma unroll
        for (int j = 0; j < 8; ++j) v[j] = vn[j];
    }
}
__device__ __forceinline__ void rstd_phase(const float* ssp, float* rstd, bool with_ctx) {
    const int nrows = with_ctx ? MT : ML;
    for (int row = blockIdx.x * NTHREADS + threadIdx.x; row < nrows; row += gridDim.x * NTHREADS) {
        float r = 1.f;
        if (row < ML) { const f32x4* p = (const f32x4*)(ssp + (size_t)row * 32); f32x4 a = p[0];
#pragma unroll
            for (int j = 1; j < 8; ++j) a = a + p[j];
            r = rsqrtf(((a.x + a.y) + (a.z + a.w)) * (1.f / D) + EPS); }
        rstd[row] = r;
    }
}
__device__ __forceinline__ void shw_phase(LAS unsigned char* lds, const float* mod, int sh_idx, const bf16* Wt, int N, float* shw) {
    const int tid = threadIdx.x, lane = tid & 63, wave = __builtin_amdgcn_readfirstlane(tid >> 6);
    LAS float* sh = (LAS float*)lds;
    __syncthreads();
    for (int i = tid; i < 8 * D / 4; i += NTHREADS) { const int r = i / (D / 4), c = (i % (D / 4)) * 4; *(LAS f32x4*)(sh + r * D + c) = *(const f32x4*)(mod + (size_t)r * NMOD + (size_t)sh_idx * D + c); }
    __syncthreads();
    for (int n = blockIdx.x * NWAVES + wave; n < N; n += gridDim.x * NWAVES) {
        float acc[8];
#pragma unroll
        for (int r = 0; r < 8; ++r) acc[r] = 0.f;
#pragma unroll 1
        for (int j = 0; j < 4; ++j) { const v4u w = *(const v4u*)(Wt + (size_t)n * D + 512 * j + 8 * lane);
            const float wf[8] = {bflo(w.x), bfhi(w.x), bflo(w.y), bfhi(w.y), bflo(w.z), bfhi(w.z), bflo(w.w), bfhi(w.w)};
#pragma unroll
            for (int r = 0; r < 8; ++r) { const f32x4 s0 = *(const LAS f32x4*)(sh + r * D + 512 * j + 8 * lane), s1 = *(const LAS f32x4*)(sh + r * D + 512 * j + 8 * lane + 4);
                acc[r] += (wf[0] * s0.x + wf[1] * s0.y) + (wf[2] * s0.z + wf[3] * s0.w) + (wf[4] * s1.x + wf[5] * s1.y) + (wf[6] * s1.z + wf[7] * s1.w); } }
#pragma unroll
        for (int r = 0; r < 8; ++r) { const float t = wave_sum(acc[r]); if (lane == r) shw[(size_t)r * N + n] = t; }
        if (lane == 8) shw[(size_t)8 * N + n] = 0.f;
    }
    __syncthreads();
}
__device__ __forceinline__ void final_norm_phase(const bf16* Hb, const float* g, float* out) {
    const int tid = threadIdx.x, lane = tid & 63, wave = __builtin_amdgcn_readfirstlane(tid >> 6);
    const int rpb = ML / gridDim.x, r0 = blockIdx.x * rpb, r1 = (blockIdx.x == gridDim.x - 1) ? ML : r0 + rpb;
    v4u v[4], vn[4];
    int row = r0 + wave;
    if (row < r1) {
#pragma unroll
        for (int j = 0; j < 4; ++j) v[j] = __builtin_nontemporal_load((const v4u*)(Hb + (size_t)row * D + 8 * lane + 512 * j));
    }
    for (; row < r1; row += NWAVES) {
        const int nr = row + NWAVES;
        if (nr < r1) {
#pragma unroll
            for (int j = 0; j < 4; ++j) vn[j] = __builtin_nontemporal_load((const v4u*)(Hb + (size_t)nr * D + 8 * lane + 512 * j));
        }
        float ss = 0.f;
#pragma unroll
        for (int j = 0; j < 4; ++j)
#pragma unroll
            for (int q = 0; q < 4; ++q) { const float a = bflo(v[j][q]), b2 = bfhi(v[j][q]); ss += a * a + b2 * b2; }
        const float rstd = rsqrtf(wave_sum(ss) * (1.f / D) + EPS);
#pragma unroll
        for (int j = 0; j < 4; ++j) { const int c = 8 * lane + 512 * j; const f32x4 g0 = *(const f32x4*)(g + c), g1 = *(const f32x4*)(g + c + 4);
            const f32x4 o0 = (f32x4){bflo(v[j].x), bfhi(v[j].x), bflo(v[j].y), bfhi(v[j].y)} * rstd * g0, o1 = (f32x4){bflo(v[j].z), bfhi(v[j].z), bflo(v[j].w), bfhi(v[j].w)} * rstd * g1;
            *(f32x4*)(out + (size_t)row * D + c) = o0; *(f32x4*)(out + (size_t)row * D + c + 4) = o1; }
#pragma unroll
        for (int j = 0; j < 4; ++j) v[j] = vn[j];
    }
}

__device__ __forceinline__ void conv_phase(const bf16* Bb, const bf16* Zb, const float* cw, bf16* V) {
    constexpr int R = 8, NTASK = (MT / R) * (D / 8);
    for (int task = blockIdx.x * NTHREADS + threadIdx.x; task < NTASK; task += gridDim.x * NTHREADS) {
        const int row0 = (task >> 8) * R, c = (task & 255) * 8;
        const int sl = row0 < ML ? SEQ : CTXL, s0 = row0 < ML ? (row0 & (SEQ - 1)) : ((row0 - ML) & (CTXL - 1));
        v4u z[R + 2], bb[R];
        z[0] = (v4u){0u, 0u, 0u, 0u}; z[R + 1] = (v4u){0u, 0u, 0u, 0u};
        if (s0 > 0) z[0] = *(const v4u*)(Zb + (size_t)(row0 - 1) * D + c);
#pragma unroll
        for (int i = 0; i < R; ++i) { z[i + 1] = *(const v4u*)(Zb + (size_t)(row0 + i) * D + c); bb[i] = __builtin_nontemporal_load((const v4u*)(Bb + (size_t)(row0 + i) * D + c)); }
        if (s0 + R < sl) z[R + 1] = *(const v4u*)(Zb + (size_t)(row0 + R) * D + c);
        const f32x4 w0a = *(const f32x4*)(cw + c), w0b = *(const f32x4*)(cw + c + 4), w1a = *(const f32x4*)(cw + D + c), w1b = *(const f32x4*)(cw + D + c + 4),
                    w2a = *(const f32x4*)(cw + 2 * D + c), w2b = *(const f32x4*)(cw + 2 * D + c + 4);
        const float w0[8] = {w0a.x, w0a.y, w0a.z, w0a.w, w0b.x, w0b.y, w0b.z, w0b.w}, w1[8] = {w1a.x, w1a.y, w1a.z, w1a.w, w1b.x, w1b.y, w1b.z, w1b.w},
                    w2[8] = {w2a.x, w2a.y, w2a.z, w2a.w, w2b.x, w2b.y, w2b.z, w2b.w};
#pragma unroll
        for (int i = 0; i < R; ++i) {
            v4u o;
#pragma unroll
            for (int q = 0; q < 4; ++q) {
                const float lo = bflo(bb[i][q]) * (w0[2 * q] * bflo(z[i][q]) + w1[2 * q] * bflo(z[i + 1][q]) + w2[2 * q] * bflo(z[i + 2][q]));
                const float hi = bfhi(bb[i][q]) * (w0[2 * q + 1] * bfhi(z[i][q]) + w1[2 * q + 1] * bfhi(z[i + 1][q]) + w2[2 * q + 1] * bfhi(z[i + 2][q]));
                o[q] = pk2(lo, hi);
            }
            *(v4u*)(V + (size_t)(row0 + i) * D + c) = o;
        }
    }
}

namespace att {
constexpr int KROW = 272, VROW = 144, KBUF = 64 * KROW, VBUF = 128 * VROW, BUF = KBUF + VBUF;
__device__ __forceinline__ int pi32(int i) { return (i & ~0xC) | ((i & 4) << 1) | ((i & 8) >> 1); }
__device__ __forceinline__ float hmax(float v) { auto rr = __builtin_amdgcn_permlane32_swap(__float_as_uint(v), __float_as_uint(v), false, false); return fmaxf(__uint_as_float(rr[0]), __uint_as_float(rr[1])); }
__device__ __forceinline__ float hsum(float v) { auto rr = __builtin_amdgcn_permlane32_swap(__float_as_uint(v), __float_as_uint(v), false, false); return __uint_as_float(rr[0]) + __uint_as_float(rr[1]); }

__device__ __forceinline__ void attn_phase(LAS unsigned char* lds, const bf16* QK, const bf16* VT, bf16* O, const float* sink) {
    const int tid = threadIdx.x, lane = tid & 63, wid = __builtin_amdgcn_readfirstlane(tid >> 6), r32 = lane & 31, hi = lane >> 5;
    for (int u = blockIdx.x; u < BATCH * 16 * 4 * 2; u += gridDim.x) {
        const int p = u & 1, hk = (u >> 1) & 3, n = (u >> 3) & 15, b = u >> 7;
        const int head = 4 * hk + 2 * p + (wid >> 2), a0 = 32 * (wid & 3);
        const int qtok = b * SEQ + 128 * n + a0 + r32;
        bf16x8 qf[8];
#pragma unroll
        for (int d0 = 0; d0 < 8; ++d0) qf[d0] = *(const bf16x8*)(QK + (size_t)qtok * NQK + head * 128 + 16 * d0 + 8 * hi);
        float m = sink[head] * LOG2E, l = hi == 0 ? 1.f : 0.f;
        f32x16 o[4];
#pragma unroll
        for (int i = 0; i < 4; ++i)
#pragma unroll
            for (int r = 0; r < 16; ++r) o[i][r] = 0.f;
        const int lo = n > 0 ? n - 1 : 0, hib = n < 15 ? n + 1 : 15, nloc = 2 * (hib - lo + 1), nt = nloc + 4;
        v4u kr[2], vr[2];
        auto load_tile = [&](int t) {
            const int ktok = t < nloc ? b * SEQ + 128 * (lo + (t >> 1)) + 64 * (t & 1) : ML + b * CTXL + 64 * (t - nloc);
#pragma unroll
            for (int i = 0; i < 2; ++i) { const int c = tid + 512 * i;
                kr[i] = *(const v4u*)(QK + (size_t)(ktok + (c >> 4)) * NQK + D + hk * 128 + (c & 15) * 8);
                vr[i] = *(const v4u*)(VT + (size_t)(hk * 128 + (c >> 3)) * MT + ktok + (c & 7) * 8); }
        };
        auto store_tile = [&](int buf) {
            LAS unsigned char* kb = lds + buf * BUF; LAS unsigned char* vb = kb + KBUF;
#pragma unroll
            for (int i = 0; i < 2; ++i) { const int c = tid + 512 * i;
                *(LAS v4u*)(kb + (c >> 4) * KROW + (c & 15) * 16) = kr[i];
                *(LAS v4u*)(vb + (c >> 3) * VROW + (c & 7) * 16) = vr[i]; }
        };
        load_tile(0); store_tile(0); __syncthreads();
        for (int t = 0; t < nt; ++t) {
            if (t + 1 < nt) load_tile(t + 1);
            const LAS unsigned char* kb = lds + (t & 1) * BUF; const LAS unsigned char* vb = kb + KBUF;
            const int kblk = t < nloc ? lo + (t >> 1) : n, c0t = 64 * (t & 1);
            const bool below = kblk < n, above = kblk > n;
            const bool dead = below ? (c0t + 63 < a0) : (above ? (c0t > a0 + 31) : false);
            const bool full = below ? (c0t >= a0 + 31) : (above ? (c0t + 63 <= a0) : true);
            if (!dead) {
            f32x16 s0, s1;
#pragma unroll
            for (int r = 0; r < 16; ++r) { s0[r] = 0.f; s1[r] = 0.f; }
            const int krow = pi32(r32);
#pragma unroll
            for (int d0 = 0; d0 < 8; ++d0) {
                const bf16x8 k0 = *(const LAS bf16x8*)(kb + krow * KROW + (2 * d0 + hi) * 16);
                const bf16x8 k1 = *(const LAS bf16x8*)(kb + (32 + krow) * KROW + (2 * d0 + hi) * 16);
                s0 = __builtin_amdgcn_mfma_f32_32x32x16_bf16(k0, qf[d0], s0, 0, 0, 0);
                s1 = __builtin_amdgcn_mfma_f32_32x32x16_bf16(k1, qf[d0], s1, 0, 0, 0);
            }
            if (!full) {
                const int a = a0 + r32, cb = c0t + 8 * hi;
#pragma unroll
                for (int r = 0; r < 16; ++r) { const int c0 = cb + 16 * (r >> 3) + (r & 7), c1 = c0 + 32;
                    const bool v0 = below ? (c0 >= a) : (c0 <= a), v1 = below ? (c1 >= a) : (c1 <= a);
                    s0[r] = v0 ? s0[r] : -1e30f; s1[r] = v1 ? s1[r] : -1e30f; }
            }
            float mx = fmaxf(s0[0], s1[0]);
#pragma unroll
            for (int r = 1; r < 16; ++r) mx = fmaxf(mx, fmaxf(s0[r], s1[r]));
            mx = hmax(mx);
            if (__any(mx > m)) {
                const float mn = fmaxf(m, mx), al = __builtin_amdgcn_exp2f(m - mn); m = mn; l *= al;
#pragma unroll
                for (int i = 0; i < 4; ++i)
#pragma unroll
                    for (int r = 0; r < 16; ++r) o[i][r] *= al;
            }
            float ps = 0.f;
#pragma unroll
            for (int r = 0; r < 16; ++r) { s0[r] = __builtin_amdgcn_exp2f(s0[r] - m); s1[r] = __builtin_amdgcn_exp2f(s1[r] - m); ps += s0[r] + s1[r]; }
            l += ps;
#pragma unroll
            for (int ks = 0; ks < 4; ++ks) {
                v4u pw;
                if (ks < 2) { const int q0 = 8 * (ks & 1); pw.x = pk2(s0[q0], s0[q0 + 1]); pw.y = pk2(s0[q0 + 2], s0[q0 + 3]); pw.z = pk2(s0[q0 + 4], s0[q0 + 5]); pw.w = pk2(s0[q0 + 6], s0[q0 + 7]); }
                else { const int q0 = 8 * (ks & 1); pw.x = pk2(s1[q0], s1[q0 + 1]); pw.y = pk2(s1[q0 + 2], s1[q0 + 3]); pw.z = pk2(s1[q0 + 4], s1[q0 + 5]); pw.w = pk2(s1[q0 + 6], s1[q0 + 7]); }
                const bf16x8 pb = __builtin_bit_cast(bf16x8, pw);
#pragma unroll
                for (int db = 0; db < 4; ++db) {
                    const bf16x8 vf = *(const LAS bf16x8*)(vb + (32 * db + r32) * VROW + (2 * ks + hi) * 16);
                    o[db] = __builtin_amdgcn_mfma_f32_32x32x16_bf16(vf, pb, o[db], 0, 0, 0);
                }
            }
            }
            if (t + 1 < nt) store_tile((t + 1) & 1);
            __syncthreads();
        }
        const float inv = 1.f / hsum(l);
        bf16* op = O + (size_t)qtok * D + head * 128 + 4 * hi;
#pragma unroll
        for (int db = 0; db < 4; ++db)
#pragma unroll
            for (int r4 = 0; r4 < 4; ++r4) { v2u w; w.x = pk2(o[db][4 * r4] * inv, o[db][4 * r4 + 1] * inv); w.y = pk2(o[db][4 * r4 + 2] * inv, o[db][4 * r4 + 3] * inv);
                *(v2u*)(op + 32 * db + 8 * r4) = w; }
    }
}
}

#define XB_TMO      128
#define XB_XCNT(j)  (256  + 64 * (j))
#define XB_XSUB(j)  (1280 + 64 * (j))
#define XB_XGEN(j)  (2304 + 64 * (j))
#define XB_TOP      3328
#define XB_TOPGEN   3392
#define XCD_BAR_WORDS 3456
#define XB_SPIN_CAP (1u << 18)
__device__ __forceinline__ unsigned xb_ld(unsigned* p)              { return __hip_atomic_load(p, __ATOMIC_RELAXED, __HIP_MEMORY_SCOPE_AGENT); }
__device__ __forceinline__ unsigned xb_add(unsigned* p, unsigned v) { return __hip_atomic_fetch_add(p, v, __ATOMIC_RELAXED, __HIP_MEMORY_SCOPE_AGENT); }
__device__ __forceinline__ unsigned xb_xcc_id() { return (unsigned)__builtin_amdgcn_s_getreg((3 << 11) | 20) & 0xFu; }
#define XB_SPIN(cond, bar) do { unsigned _sp = 0; while (cond) { __builtin_amdgcn_s_sleep(1); \
    if ((++_sp & 255u) == 0u) { if (xb_ld(&(bar)[XB_TMO])) break; if (_sp > XB_SPIN_CAP) { atomicAdd(&(bar)[XB_TMO], 1u); break; } } } } while (0)
struct XcdBarrier { unsigned* bar; unsigned x; volatile LAS unsigned* st; };
__device__ __forceinline__ XcdBarrier xcd_barrier_post(unsigned* bar, volatile LAS unsigned* st) {
    XcdBarrier b; b.bar = bar; b.x = xb_xcc_id(); b.st = st;
    if (threadIdx.x == 0) (void)xb_add(&bar[XB_XCNT(b.x)], 1u);
    return b;
}
__device__ __forceinline__ void xcd_barrier_complete(unsigned* bar, unsigned x, unsigned& nloc, unsigned& nx) {
    const unsigned G = gridDim.x * gridDim.y * gridDim.z;
    unsigned sum, cnt, mine, sp = 0u;
    for (;;) {
        sum = 0u; cnt = 0u; mine = 0u;
#pragma unroll
        for (unsigned j = 0; j < 16; ++j) { const unsigned c = xb_ld(&bar[XB_XCNT(j)]); sum += c; cnt += (c > 0u) ? 1u : 0u; mine = (j == x) ? c : mine; }
        if (sum == G) break;
        __builtin_amdgcn_s_sleep(1);
        if ((++sp & 255u) == 0u) { if (xb_ld(&bar[XB_TMO])) break; if (sp > XB_SPIN_CAP) { atomicAdd(&bar[XB_TMO], 1u); break; } }
    }
    nloc = mine > 0u ? mine : 1u; nx = cnt > 0u ? cnt : 1u;
}
__device__ __forceinline__ void xcd_barrier(const XcdBarrier& b) {
    asm volatile("s_waitcnt vmcnt(0)" ::: "memory");
    __syncthreads();
    if (threadIdx.x == 0) {
        unsigned* bar = b.bar;
        __builtin_amdgcn_s_waitcnt(0);
        unsigned nloc = b.st[0], nx = b.st[1];
        if (nloc == 0u) { xcd_barrier_complete(bar, b.x, nloc, nx); b.st[0] = nloc; b.st[1] = nx; }
        const unsigned old = xb_add(&bar[XB_XSUB(b.x)], 1u);
        const unsigned gen = old / nloc;
        if (old + 1u == (gen + 1u) * nloc) {
            __builtin_amdgcn_fence(__ATOMIC_RELEASE, "agent");
            asm volatile("s_waitcnt vmcnt(0)" ::: "memory");
            const unsigned og = xb_add(&bar[XB_TOP], 1u);
            const unsigned tg = og / nx;
            if (og + 1u == (tg + 1u) * nx) xb_add(&bar[XB_TOPGEN], 1u);
            else XB_SPIN(xb_ld(&bar[XB_TOPGEN]) == tg, bar);
            __builtin_amdgcn_fence(__ATOMIC_ACQUIRE, "agent");
            xb_add(&bar[XB_XGEN(b.x)], 1u);
            asm volatile("s_waitcnt vmcnt(0)" ::: "memory");
        } else {
            XB_SPIN(xb_ld(&bar[XB_XGEN(b.x)]) == gen, bar);
            __builtin_amdgcn_fence(__ATOMIC_ACQUIRE, "agent");
            asm volatile("s_waitcnt vmcnt(0)" ::: "memory");
        }
    }
    __syncthreads();
}

constexpr int NPHASE = 16;
__global__ void __launch_bounds__(NTHREADS, 2) fwd_megakernel(Args args) {
    extern __shared__ __attribute__((aligned(16))) unsigned char lds_raw[];
    LAS unsigned char* lds = (LAS unsigned char*)lds_raw;
    cg::grid_group grid = cg::this_grid();
    unsigned char* ws = args.ws;
    const int lo = args.ph_lo, hi = args.ph_hi, G = gridDim.x, bx = blockIdx.x;
    const float* x = args.in[0]; const float* ctx = args.in[2];
    float* MOD = (float*)(ws + WS_MOD); bf16* Hb = (bf16*)(ws + WS_H);
    bf16* U = (bf16*)(ws + WS_U); bf16* R1 = (bf16*)(ws + WS_R1);
    bf16* Bb = (bf16*)(ws + WS_R1 + R1_B); bf16* Zb = (bf16*)(ws + WS_R1 + R1_Z); bf16* Vb = (bf16*)(ws + WS_R1 + R1_V);
    bf16* QKb = (bf16*)(ws + WS_R1 + R1_QK); bf16* VTb = (bf16*)(ws + WS_R1 + R1_VT); bf16* Ob = (bf16*)(ws + WS_R1 + R1_O);
    const float* MOD0 = MOD; const float* MOD1 = MOD + 9 * NMOD;
#define IN(k) (lo <= (k) && (k) < hi)
#define SEAM(k) do { if (IN(k) && IN((k) + 1)) xcd_barrier(bar); } while (0)
    typedef pg8::StaticOrder SO;
    unsigned* barw = (unsigned*)(ws + WS_BAR);
    volatile LAS unsigned* MISC = (volatile LAS unsigned*)(lds + RING_BYTES);
    if (threadIdx.x < 16) MISC[threadIdx.x] = 0u;
    __syncthreads();
    XcdBarrier bar; bar.bar = barw; bar.x = 0; bar.st = MISC + 8;
    float* PART = (float*)(ws + WS_PART);
    float* Hc = (float*)(ws + WS_H + 64 * MiB);

    if (IN(0)) {
        if (bx == 0) for (int i = threadIdx.x; i < XCD_BAR_WORDS; i += NTHREADS) barw[i] = 0u;
        p0_prologue(args, lds);
        if (IN(1)) { grid.sync(); bar = xcd_barrier_post(barw, MISC + 8); }
    }
    float* SSP = (float*)(ws + WS_SSP); float* RSTD = (float*)(ws + WS_RSTD);
    float* SHWA = (float*)(ws + WS_SHW); float* SHWB = SHWA + 9 * FF; float* SHWC = SHWB + 9 * 3072;
    const float* MODC = MOD0 + (size_t)BATCH * NMOD;
    if (IN(1)) { norm_mod_phase(x, ctx, 0, MT, args.in[4], MOD0, 0, U);
        shw_phase(lds, MOD0, 3, (const bf16*)(ws + WS_W1), FF, SHWA); shw_phase(lds, MOD1, 0, (const bf16*)(ws + WS_WQK), 3072, SHWB); } SEAM(1);
    if (IN(2)) { pg8::Gemm g{U, (const bf16*)(ws + WS_WIN), nullptr, nullptr, D}; SO S; S.init(MT, 3 * D, D, G, bx); pg8::EpiConvIn E{Bb, Zb};
        pg8::gemm_phase<pg8::EpiConvIn, SO, true, true>(lds, g, S, E); tail_transposes(args, lds, (MT / 256) * (3 * D / 256), TR_P0, TR_T1); } SEAM(2);
    if (IN(3)) { conv_phase(Bb, Zb, args.in[9], Vb); } SEAM(3);
    if (IN(4)) { pg8::Gemm g{Vb, (const bf16*)(ws + WS_WOUT), nullptr, nullptr, D};
        { SO S; S.init(ML, D, D, G, bx); pg8::EpiResid<true, false> E{x, Hb, MOD0 + 2 * D, args.in[5], MOD0 + 4 * D, U, SSP}; pg8::gemm_phase<pg8::EpiResid<true, false>, SO, true, true>(lds, g, S, E); }
        { pg8::QuarterOrder S; S.init(D, G, bx); pg8::EpiPart E{PART, D / 4}; pg8::gemm_phase<pg8::EpiPart, pg8::QuarterOrder, true, true>(lds, g, S, E); } } SEAM(4);
    if (IN(5)) { norm_mod_phase(nullptr, ctx, ML, MT, args.in[5], MOD0, 3, U, PART, MODC + 2 * D, Hc); rstd_phase(SSP, RSTD, true); } SEAM(5);
    if (IN(6)) { pg8::Gemm g{U, (const bf16*)(ws + WS_W1), nullptr, nullptr, D}; SO S; S.init(MT, FF, D, G, bx); pg8::EpiRelu2 E{R1, RSTD, SHWA};
        pg8::gemm_phase<pg8::EpiRelu2, SO, true, true>(lds, g, S, E); } SEAM(6);
    if (IN(7)) { pg8::Gemm g{R1, (const bf16*)(ws + WS_W2), nullptr, nullptr, FF};
        { SO S; S.init(ML, D, FF, G, bx); pg8::EpiResid<true, true> E{Hb, Hb, MOD0 + 5 * D, args.in[4] + D, MOD1 + 1 * D, U, SSP}; pg8::gemm_phase<pg8::EpiResid<true, true>, SO, true, true>(lds, g, S, E); }
        { pg8::QuarterOrder S; S.init(FF, G, bx); pg8::EpiPart E{PART, FF / 4}; pg8::gemm_phase<pg8::EpiPart, pg8::QuarterOrder, true, true>(lds, g, S, E); } } SEAM(7);
    if (IN(8)) { norm_mod_phase(nullptr, Hc, ML, MT, args.in[4] + D, MOD1, 0, U, PART, MODC + 5 * D, nullptr); rstd_phase(SSP, RSTD, true); } SEAM(8);
    if (IN(9)) { pg8::Gemm g{U, (const bf16*)(ws + WS_WQK), (const bf16*)(ws + WS_WV), U, D}; pg8::QkvOrder S; S.init(G, bx); pg8::EpiQkv E{QKb, VTb, RSTD, SHWB};
        pg8::gemm_phase<pg8::EpiQkv, pg8::QkvOrder, true, true>(lds, g, S, E); tail_transposes(args, lds, (MT / 256) * (NQK / 256) + 2 * (MT / 256), TR_T1, TR_T2); } SEAM(9);
    if (IN(10)) { att::attn_phase(lds, QKb, VTb, Ob, args.in[12]); } SEAM(10);
    if (IN(11)) { pg8::Gemm g{Ob, (const bf16*)(ws + WS_WO), nullptr, nullptr, D}; SO S; S.init(ML, D, D, G, bx); pg8::EpiResid<true, true> E{Hb, Hb, MOD1 + 2 * D, args.in[5] + D, MOD1 + 4 * D, U, SSP};
        pg8::gemm_phase<pg8::EpiResid<true, true>, SO, true, true>(lds, g, S, E); } SEAM(11);
    if (IN(12)) { rstd_phase(SSP, RSTD, false); shw_phase(lds, MOD1, 3, (const bf16*)(ws + WS_W1) + W1_STRIDE, FF, SHWC); } SEAM(12);
    if (IN(13)) { pg8::Gemm g{U, (const bf16*)(ws + WS_W1) + W1_STRIDE, nullptr, nullptr, D}; SO S; S.init(ML, FF, D, G, bx); pg8::EpiRelu2 E{R1, RSTD, SHWC};
        pg8::gemm_phase<pg8::EpiRelu2, SO, true, true>(lds, g, S, E); } SEAM(13);
    if (IN(14)) { pg8::Gemm g{R1, (const bf16*)(ws + WS_W2) + W2_STRIDE, nullptr, nullptr, FF}; SO S; S.init(ML, D, FF, G, bx); pg8::EpiResid<false, true> E{Hb, Hb, MOD1 + 5 * D, nullptr, nullptr, nullptr, nullptr};
        pg8::gemm_phase<pg8::EpiResid<false, true>, SO, true, true>(lds, g, S, E); } SEAM(14);
    if (IN(15)) { final_norm_phase(Hb, args.in[16], args.out); }
#undef IN
#undef SEAM
}

extern "C" void kernel_launch(void* const* d_in, const int* in_sizes, int n_in, void* d_out, int out_size, void* d_ws, size_t ws_size, hipStream_t stream) {
    static int grid = 0;
    if (grid == 0) {
        if (n_in != 17 || in_sizes[0] != ML * D || out_size != ML * D || ws_size < WS_END) { fprintf(stderr, "kernel_launch: unexpected shapes (n_in %d, in0 %d, out %d, ws %zu); nothing launched\n", n_in, n_in > 0 ? in_sizes[0] : -1, out_size, ws_size); grid = -1; return; }
        int dev = 0, cus = 0, per_cu = 0;
        if (hipGetDevice(&dev) != hipSuccess || hipDeviceGetAttribute(&cus, hipDeviceAttributeMultiprocessorCount, dev) != hipSuccess) { grid = -1; return; }
        if (hipFuncSetAttribute((const void*)fwd_megakernel, hipFuncAttributeMaxDynamicSharedMemorySize, LDS_BYTES) != hipSuccess) { fprintf(stderr, "kernel_launch: hipFuncSetAttribute failed\n"); grid = -1; return; }
        if (hipOccupancyMaxActiveBlocksPerMultiprocessor(&per_cu, (const void*)fwd_megakernel, NTHREADS, LDS_BYTES) != hipSuccess || per_cu < 1) { fprintf(stderr, "kernel_launch: occupancy query gives %d\n", per_cu); per_cu = 1; }
        (void)hipGetLastError();
        grid = cus * 1;
    }
    if (grid < 0) return;
    Args a{};
    for (int i = 0; i < 17; ++i) a.in[i] = (const float*)d_in[i];
    a.out = (float*)d_out; a.ws = (unsigned char*)d_ws;
    if (MK_N_LAUNCHES == 1) {
        a.ph_lo = 0; a.ph_hi = NPHASE;
        void* kargs[] = {&a};
        hipError_t e = hipLaunchCooperativeKernel((const void*)fwd_megakernel, dim3(grid), dim3(NTHREADS), kargs, LDS_BYTES, stream);
        if (e != hipSuccess) fprintf(stderr, "kernel_launch: cooperative launch failed: %s (grid %d)\n", hipGetErrorString(e), grid);
    } else {
        for (int p = 0; p < NPHASE; ++p) { a.ph_lo = p; a.ph_hi = p + 1; hipLaunchKernelGGL(fwd_megakernel, dim3(grid), dim3(NTHREADS), LDS_BYTES, stream, a); }
    }
}
```

```cpp
#include <hip/hip_runtime.h>
#include <hip/hip_cooperative_groups.h>
#include <cstdio>
#include <cstdint>
namespace cg = cooperative_groups;

#ifndef MK_N_LAUNCHES
#define MK_N_LAUNCHES 1
#endif

constexpr int D = 2048, BATCH = 8, SEQ = 2048, CTXL = 256, FF = 8192, NMOD = 6 * D;
constexpr int ML = BATCH * SEQ, MC = BATCH * CTXL, MT = ML + MC;
constexpr int NQK = 2560;
constexpr float EPS = 1e-6f;
constexpr float LOG2E = 1.4426950408889634f;
constexpr float QSCALE = 0.08838834764831845f * LOG2E;

namespace pg8 {
#define PG8_LAS __attribute__((address_space(3)))
typedef unsigned short bf16_t;
typedef short bf16x8 __attribute__((ext_vector_type(8)));
typedef float f32x4 __attribute__((ext_vector_type(4)));
typedef unsigned u32x4 __attribute__((ext_vector_type(4)));
constexpr int BM = 256, BK = 64, HALF = 128, HTB = HALF * BK * 2, STAGE_BYTES = 8 * HTB, NXCD = 8, WGM = 8;

__host__ __device__ __forceinline__ int lds_byte(int r, int c) { const int st = (r >> 4) * 2 + (c >> 5), rr = r & 15, cc = c & 31, ob = rr * 64 + cc * 2; return st * 1024 + (ob ^ (((ob >> 9) & 1) << 5)); }
__host__ __device__ __forceinline__ void stage_rc(int b, int& R, int& C) { const int st = b / 1024, sb = b % 1024, swz = sb ^ (((sb >> 9) & 1) << 5); R = (st >> 1) * 16 + swz / 64; C = (st & 1) * 32 + (swz % 64) / 2; }
__host__ __device__ __forceinline__ int perm32(int rho) { const int n = rho >> 4, i = rho & 15; return 8 * (i >> 2) + 4 * n + (i & 3); }

struct Unit { int pm, pn, kind, k0, nt; };
struct Gemm { const bf16_t* A; const bf16_t* Bt; const bf16_t* A2; const bf16_t* Bt2; int K; };

struct StaticOrder {
    int nM, nN, nwg, G, c, ntk;
    __host__ __device__ void init(int M, int N, int K, int G_, int c_) { nM = M / BM; nN = N / BM; nwg = nM * nN; G = G_; c = c_; ntk = K / BK; }
    __host__ __device__ bool map(long L, Unit& u) const {
        if (L >= nwg) return false;
        int wgid = (int)L; { const int q = nwg / NXCD, r = nwg % NXCD, xcd = wgid % NXCD, off = wgid / NXCD; wgid = (xcd < r ? xcd * (q + 1) : r * (q + 1) + (xcd - r) * q) + off; }
        const int nig = WGM * nN, gid = wgid / nig, fm = gid * WGM, gsz = (nM - fm) < WGM ? (nM - fm) : WGM;
        u.pm = fm + ((wgid % nig) % gsz); u.pn = (wgid % nig) / gsz; u.kind = 0; u.k0 = 0; u.nt = ntk; return true;
    }
    __host__ __device__ bool next(int i, Unit& u) const { return map((long)i * G + c, u); }
};
struct QkvOrder {
    StaticOrder so; int nvt;
    __host__ __device__ void init(int G_, int c_) { so.init(MT, NQK, D, G_, c_); nvt = 2 * (MT / BM); }
    __host__ __device__ bool next(int i, Unit& u) const {
        const long L = (long)i * so.G + so.c;
        if (L < so.nwg) return so.map(L, u);
        const int r = (int)(L - so.nwg); if (r >= nvt) return false;
        u.pm = r / (MT / BM); u.pn = r % (MT / BM); u.kind = 1; u.k0 = 0; u.nt = so.ntk; return true;
    }
};
struct QuarterOrder {
    int G, c, ntq;
    __host__ __device__ void init(int K, int G_, int c_) { G = G_; c = c_; ntq = K / BK / 4; }
    __host__ __device__ bool next(int i, Unit& u) const {
        const int r = i * G + c; if (r >= 256) return false;
        u.pm = ML / BM + ((r & 63) >> 3); u.pn = r & 7; u.kind = 0; u.nt = ntq; u.k0 = (r >> 6) * ntq * BK; return true;
    }
};

__device__ __forceinline__ unsigned cvt_pk_bf16(float lo, float hi) { unsigned r; asm volatile("v_cvt_pk_bf16_f32 %0, %1, %2" : "=v"(r) : "v"(lo), "v"(hi)); return r; }


struct EpiConvIn {
    static constexpr bool PERM = true;
    bf16_t* Bb; bf16_t* Zb;
    __device__ __forceinline__ void operator()(const f32x4 (&acc)[2][2][4][2], const Unit& u, int wr, int wc, int fr, int fq) const {
        const int row0 = u.pm * BM + wr * 64 + fr;
        if (u.pn < 8) {
            const int col0 = u.pn * BM + wc * 32 + 8 * fq;
#pragma unroll
            for (int ai = 0; ai < 2; ++ai)
#pragma unroll
                for (int m = 0; m < 4; ++m) { bf16_t* rowp = Bb + (size_t)(row0 + ai * HALF + m * 16) * D + col0;
#pragma unroll
                    for (int bj = 0; bj < 2; ++bj) { const f32x4 v0 = acc[ai][bj][m][0], v1 = acc[ai][bj][m][1];
                        u32x4 w; w.x = cvt_pk_bf16(v0[0], v0[1]); w.y = cvt_pk_bf16(v0[2], v0[3]); w.z = cvt_pk_bf16(v1[0], v1[1]); w.w = cvt_pk_bf16(v1[2], v1[3]);
                        *(u32x4*)(rowp + bj * HALF) = w; } }
        } else {
            const int col0 = (u.pn - 8) * HALF + wc * 32 + 8 * fq;
#pragma unroll
            for (int ai = 0; ai < 2; ++ai)
#pragma unroll
                for (int m = 0; m < 4; ++m) { bf16_t* rowp = Zb + (size_t)(row0 + ai * HALF + m * 16) * D + col0;
                    const f32x4 v0 = acc[ai][0][m][0] * acc[ai][1][m][0], v1 = acc[ai][0][m][1] * acc[ai][1][m][1];
                    u32x4 w; w.x = cvt_pk_bf16(v0[0], v0[1]); w.y = cvt_pk_bf16(v0[2], v0[3]); w.z = cvt_pk_bf16(v1[0], v1[1]); w.w = cvt_pk_bf16(v1[2], v1[3]);
                    *(u32x4*)rowp = w; }
        }
    }
};
struct EpiRelu2 {
    static constexpr bool PERM = true;
    bf16_t* O; const float* rstd; const float* shw;
    __device__ __forceinline__ void operator()(const f32x4 (&acc)[2][2][4][2], const Unit& u, int wr, int wc, int fr, int fq) const {
        const int row0 = u.pm * BM + wr * 64 + fr, col0 = u.pn * BM + wc * 32 + 8 * fq;
        const int mr = u.pm < (ML / BM) ? u.pm / (SEQ / BM) : BATCH;
        f32x4 bv[2][2];
#pragma unroll
        for (int bj = 0; bj < 2; ++bj)
#pragma unroll
            for (int n = 0; n < 2; ++n) bv[bj][n] = *(const f32x4*)(shw + (size_t)mr * FF + col0 + bj * HALF + 4 * n);
#pragma unroll
        for (int ai = 0; ai < 2; ++ai)
#pragma unroll
            for (int m = 0; m < 4; ++m) { const int row = row0 + ai * HALF + m * 16; bf16_t* rowp = O + (size_t)row * FF + col0; const float rs = rstd[row];
#pragma unroll
                for (int bj = 0; bj < 2; ++bj) { f32x4 v0 = acc[ai][bj][m][0] * rs + bv[bj][0], v1 = acc[ai][bj][m][1] * rs + bv[bj][1];
#pragma unroll
                    for (int e = 0; e < 4; ++e) { const float a = fmaxf(v0[e], 0.f), b = fmaxf(v1[e], 0.f); v0[e] = a * a; v1[e] = b * b; }
                    u32x4 w; w.x = cvt_pk_bf16(v0[0], v0[1]); w.y = cvt_pk_bf16(v0[2], v0[3]); w.z = cvt_pk_bf16(v1[0], v1[1]); w.w = cvt_pk_bf16(v1[2], v1[3]);
                    *(u32x4*)(rowp + bj * HALF) = w; } }
    }
};
template <bool NP, bool BASE_BF16> struct EpiResid {
    static constexpr bool PERM = true;
    const void* base; bf16_t* Hb; const float* gate;
    const float* ng; const float* ns; bf16_t* U; float* ssp;
    __device__ __forceinline__ void operator()(const f32x4 (&acc)[2][2][4][2], const Unit& u, int wr, int wc, int fr, int fq) const {
        const int col0 = u.pn * BM + wc * 32 + 8 * fq;
        const int mr = u.pm / (SEQ / BM);
        const float* gp = gate + (size_t)mr * NMOD + col0;
        float ss[2][4];
#pragma unroll
        for (int ai = 0; ai < 2; ++ai)
#pragma unroll
            for (int m = 0; m < 4; ++m) ss[ai][m] = 0.f;
#pragma unroll
        for (int bj = 0; bj < 2; ++bj) {
            f32x4 gv[2], gs[2];
#pragma unroll
            for (int n = 0; n < 2; ++n) { gv[n] = *(const f32x4*)(gp + bj * HALF + 4 * n);
                if constexpr (NP) gs[n] = *(const f32x4*)(ng + col0 + bj * HALF + 4 * n) * (*(const f32x4*)(ns + (size_t)mr * NMOD + col0 + bj * HALF + 4 * n) + 1.f); }
#pragma unroll
            for (int ai = 0; ai < 2; ++ai)
#pragma unroll
                for (int m = 0; m < 4; ++m) { const size_t off = (size_t)(u.pm * BM + ai * HALF + wr * 64 + m * 16 + fr) * D + col0 + bj * HALF;
                    f32x4 b0, b1;
                    if constexpr (BASE_BF16) { const u32x4 w = *(const u32x4*)((const bf16_t*)base + off);
                        b0 = (f32x4){__uint_as_float(w.x << 16), __uint_as_float(w.x & 0xffff0000u), __uint_as_float(w.y << 16), __uint_as_float(w.y & 0xffff0000u)};
                        b1 = (f32x4){__uint_as_float(w.z << 16), __uint_as_float(w.z & 0xffff0000u), __uint_as_float(w.w << 16), __uint_as_float(w.w & 0xffff0000u)}; }
                    else { b0 = *(const f32x4*)((const float*)base + off); b1 = *(const f32x4*)((const float*)base + off + 4); }
                    const f32x4 h0 = b0 + gv[0] * acc[ai][bj][m][0], h1 = b1 + gv[1] * acc[ai][bj][m][1];
                    u32x4 hw; hw.x = cvt_pk_bf16(h0[0], h0[1]); hw.y = cvt_pk_bf16(h0[2], h0[3]); hw.z = cvt_pk_bf16(h1[0], h1[1]); hw.w = cvt_pk_bf16(h1[2], h1[3]);
                    *(u32x4*)(Hb + off) = hw;
                    if constexpr (NP) { ss[ai][m] += ((h0[0] * h0[0] + h0[1] * h0[1]) + (h0[2] * h0[2] + h0[3] * h0[3])) + ((h1[0] * h1[0] + h1[1] * h1[1]) + (h1[2] * h1[2] + h1[3] * h1[3]));
                        const f32x4 t0 = h0 * gs[0], t1 = h1 * gs[1];
                        u32x4 uw; uw.x = cvt_pk_bf16(t0[0], t0[1]); uw.y = cvt_pk_bf16(t0[2], t0[3]); uw.z = cvt_pk_bf16(t1[0], t1[1]); uw.w = cvt_pk_bf16(t1[2], t1[3]);
                        *(u32x4*)(U + off) = uw; } }
            asm volatile("" ::: "memory");
        }
        if constexpr (NP) {
#pragma unroll
            for (int ai = 0; ai < 2; ++ai)
#pragma unroll
                for (int m = 0; m < 4; ++m) { float t = ss[ai][m]; t += __shfl_xor(t, 16); t += __shfl_xor(t, 32);
                    if (fq == 0) ssp[(size_t)(u.pm * BM + ai * HALF + wr * 64 + m * 16 + fr) * 32 + u.pn * 4 + wc] = t; }
        }
    }
};
struct EpiPart {
    static constexpr bool PERM = false;
    float* part; int kq;
    __device__ __forceinline__ void operator()(const f32x4 (&acc)[2][2][4][2], const Unit& u, int wr, int wc, int fr, int fq) const {
        float* pp = part + ((size_t)(u.k0 / kq) * MC + (size_t)(u.pm - ML / BM) * BM) * D + u.pn * BM + wc * 32 + 4 * fq;
#pragma unroll
        for (int ai = 0; ai < 2; ++ai)
#pragma unroll
            for (int m = 0; m < 4; ++m) { const size_t off = (size_t)(ai * HALF + wr * 64 + m * 16 + fr) * D;
#pragma unroll
                for (int bj = 0; bj < 2; ++bj)
#pragma unroll
                    for (int n = 0; n < 2; ++n) *(f32x4*)(pp + off + bj * HALF + n * 16) = acc[ai][bj][m][n]; }
    }
};
struct EpiQkv {
    static constexpr bool PERM = true;
    bf16_t* QK; bf16_t* VT; const float* rstd; const float* shw;
    __device__ __forceinline__ void operator()(const f32x4 (&acc)[2][2][4][2], const Unit& u, int wr, int wc, int fr, int fq) const {
        const int row0 = u.pm * BM + wr * 64 + fr, col0 = u.pn * BM + wc * 32 + 8 * fq;
        if (u.kind == 1) {
            const int mrt = u.pn < (ML / BM) ? u.pn / (SEQ / BM) : BATCH;
            f32x4 rv[2][2];
#pragma unroll
            for (int bj = 0; bj < 2; ++bj)
#pragma unroll
                for (int n = 0; n < 2; ++n) rv[bj][n] = *(const f32x4*)(rstd + col0 + bj * HALF + 4 * n);
#pragma unroll
            for (int ai = 0; ai < 2; ++ai)
#pragma unroll
                for (int m = 0; m < 4; ++m) { const int drow = row0 + ai * HALF + m * 16; bf16_t* rowp = VT + (size_t)drow * MT + col0; const float bb = shw[(size_t)mrt * 3072 + NQK + drow];
#pragma unroll
                    for (int bj = 0; bj < 2; ++bj) { const f32x4 v0 = acc[ai][bj][m][0] * rv[bj][0] + bb, v1 = acc[ai][bj][m][1] * rv[bj][1] + bb;
                        u32x4 w; w.x = cvt_pk_bf16(v0[0], v0[1]); w.y = cvt_pk_bf16(v0[2], v0[3]); w.z = cvt_pk_bf16(v1[0], v1[1]); w.w = cvt_pk_bf16(v1[2], v1[3]);
                        *(u32x4*)(rowp + bj * HALF) = w; } }
            return;
        }
        const bool lat = u.pm < (ML / BM);
        const float sc = u.pn < 8 ? QSCALE : 1.f;
        const int mrq = lat ? u.pm / (SEQ / BM) : BATCH;
        f32x4 bq[2][2];
#pragma unroll
        for (int bj = 0; bj < 2; ++bj)
#pragma unroll
            for (int n = 0; n < 2; ++n) bq[bj][n] = *(const f32x4*)(shw + (size_t)mrq * 3072 + col0 + bj * HALF + 4 * n);
        float invf[2][2];
#pragma unroll
        for (int n = 0; n < 2; ++n)
#pragma unroll
            for (int j = 0; j < 2; ++j) { const int f = 16 * (wc & 1) + 4 * fq + 2 * n + j; invf[n][j] = exp2f(-(float)f * (13.287712379549449f / 32.f)); }
#pragma unroll
        for (int ai = 0; ai < 2; ++ai)
#pragma unroll
            for (int m = 0; m < 4; ++m) {
                const int row = row0 + ai * HALF + m * 16; const int s = row & (SEQ - 1);
                const float pos = (float)((wc >> 1) ? (s & 63) : (s >> 6));
                float cs[2][2], sn[2][2];
#pragma unroll
                for (int n = 0; n < 2; ++n)
#pragma unroll
                    for (int j = 0; j < 2; ++j) { const float ang = pos * invf[n][j]; cs[n][j] = lat ? __cosf(ang) : 1.f; sn[n][j] = lat ? __sinf(ang) : 0.f; }
                bf16_t* rowp = QK + (size_t)row * NQK + col0; const float rs = rstd[row];
#pragma unroll
                for (int bj = 0; bj < 2; ++bj) { f32x4 v[2] = {acc[ai][bj][m][0] * rs + bq[bj][0], acc[ai][bj][m][1] * rs + bq[bj][1]};
#pragma unroll
                    for (int n = 0; n < 2; ++n)
#pragma unroll
                        for (int j = 0; j < 2; ++j) { const float x0 = v[n][2 * j], x1 = v[n][2 * j + 1];
                            v[n][2 * j] = (x0 * cs[n][j] - x1 * sn[n][j]) * sc; v[n][2 * j + 1] = (x1 * cs[n][j] + x0 * sn[n][j]) * sc; }
                    u32x4 w; w.x = cvt_pk_bf16(v[0][0], v[0][1]); w.y = cvt_pk_bf16(v[0][2], v[0][3]); w.z = cvt_pk_bf16(v[1][0], v[1][1]); w.w = cvt_pk_bf16(v[1][2], v[1][3]);
                    *(u32x4*)(rowp + bj * HALF) = w; }
            }
    }
};

template <class Epi, class Sched, bool ALIGN_EPI = false, bool SP2 = false>
__device__ __forceinline__ void gemm_phase(PG8_LAS unsigned char* lds, const Gemm g, const Sched& S, const Epi& E) {
    const int tid = threadIdx.x, wid = __builtin_amdgcn_readfirstlane(tid >> 6), lane = tid & 63, wr = wid >> 2, wc = wid & 3, fr = lane & 15, fq = lane >> 4;
    const int K = g.K;
    unsigned voffA[2], voffB[2];
#pragma unroll
    for (int i = 0; i < 2; ++i) { int R, C; stage_rc(tid * 16 + i * 8192, R, C); const int Rb = Epi::PERM ? ((R & ~31) + perm32(R & 31)) : R;
        voffA[i] = (unsigned)(R * K + C) * 2u; voffB[i] = (unsigned)(Rb * K + C) * 2u; }
    const size_t kstep = (size_t)(BK * 2);
    const size_t hstep = (size_t)HALF * K * 2;
    const size_t tstep = 2 * hstep;
    const unsigned ldsw = (unsigned)wid * 1024u;
    const int aoff = lds_byte(wr * 64 + fr, fq * 8), boff = lds_byte(wc * 32 + fr, fq * 8);
#define PG8_SA(b, h) (((b) * 2 + (h)) * HTB)
#define PG8_SB(b, h) ((4 + (b) * 2 + (h)) * HTB)
#define PG8_STAGE(bufoff, gbase, voff) do { _Pragma("unroll") for (int _i = 0; _i < 2; ++_i) \
        __builtin_amdgcn_global_load_lds((const unsigned*)((const char*)(gbase) + (voff)[_i]), (PG8_LAS unsigned*)(lds + (bufoff) + ldsw + _i * 8192), 16, 0, 0); } while (0)
#define PG8_LDA(dst, b, h) do { _Pragma("unroll") for (int m = 0; m < 4; ++m) _Pragma("unroll") for (int k = 0; k < 2; ++k) dst[m][k] = *(const PG8_LAS bf16x8*)(lds + PG8_SA(b, h) + aoff + m * 2048 + k * 1024); } while (0)
#define PG8_LDB(dst, b, h) do { _Pragma("unroll") for (int n = 0; n < 2; ++n) _Pragma("unroll") for (int k = 0; k < 2; ++k) dst[n][k] = *(const PG8_LAS bf16x8*)(lds + PG8_SB(b, h) + boff + n * 2048 + k * 1024); } while (0)
#define PG8_MMA(ai, bj, At, Bt) do { __builtin_amdgcn_s_setprio(1); _Pragma("unroll") for (int m = 0; m < 4; ++m) _Pragma("unroll") for (int n = 0; n < 2; ++n) _Pragma("unroll") for (int k = 0; k < 2; ++k) \
        acc[ai][bj][m][n] = __builtin_amdgcn_mfma_f32_16x16x32_bf16(Bt[n][k], At[m][k], acc[ai][bj][m][n], 0, 0, 0); __builtin_amdgcn_s_setprio(0); } while (0)
#define PG8_WAIT_V(n) asm volatile("s_waitcnt vmcnt(" #n ")" ::: "memory")
#define PG8_WAIT_L(n) asm volatile("s_waitcnt lgkmcnt(" #n ")" ::: "memory")
#define PG8_BAR __builtin_amdgcn_s_barrier()
#define PG8_SCHED __builtin_amdgcn_sched_barrier(0)
#define PG8_UA(u) ((const char*)((u).kind ? g.A2 : g.A) + (size_t)(u).pm * tstep + (size_t)(u).k0 * 2)
#define PG8_UB(u) ((const char*)((u).kind ? g.Bt2 : g.Bt) + (size_t)(u).pn * tstep + (size_t)(u).k0 * 2)
    Unit cur, nxt; int ui = 0;
    if (!S.next(0, cur)) return;
    f32x4 acc[2][2][4][2];
#pragma unroll
    for (int a = 0; a < 2; ++a)
#pragma unroll
        for (int b = 0; b < 2; ++b)
#pragma unroll
            for (int m = 0; m < 4; ++m)
#pragma unroll
                for (int n = 0; n < 2; ++n) acc[a][b][m][n] = (f32x4){0.f, 0.f, 0.f, 0.f};
    bf16x8 At[4][2], B0[2][2], B1[2][2];
    const char* cA = PG8_UA(cur); const char* cB = PG8_UB(cur);
    if constexpr (SP2) {
        PG8_STAGE(PG8_SB(0, 0), cB, voffB); PG8_STAGE(PG8_SB(0, 1), cB + hstep, voffB); PG8_STAGE(PG8_SA(0, 0), cA, voffA); PG8_STAGE(PG8_SA(0, 1), cA + hstep, voffA);
        if (wr == 1) PG8_BAR;
        PG8_WAIT_V(2); PG8_BAR;
        PG8_STAGE(PG8_SB(1, 0), cB + kstep, voffB); PG8_STAGE(PG8_SA(1, 0), cA + kstep, voffA); PG8_STAGE(PG8_SB(1, 1), cB + hstep + kstep, voffB);
        PG8_WAIT_V(6); PG8_BAR;
    } else {
        PG8_STAGE(PG8_SB(0, 0), cB, voffB); PG8_STAGE(PG8_SA(0, 0), cA, voffA); PG8_STAGE(PG8_SB(0, 1), cB + hstep, voffB); PG8_STAGE(PG8_SA(0, 1), cA + hstep, voffA);
        if (wr == 1) PG8_BAR;
        PG8_WAIT_V(4); PG8_BAR;
        PG8_STAGE(PG8_SB(1, 0), cB + kstep, voffB); PG8_STAGE(PG8_SA(1, 0), cA + kstep, voffA); PG8_STAGE(PG8_SB(1, 1), cB + hstep + kstep, voffB);
        PG8_WAIT_V(6); PG8_BAR;
    }
    for (;;) {
        const bool has_next = S.next(ui + 1, nxt);
        const char* nA = has_next ? PG8_UA(nxt) : cA; const char* nB = has_next ? PG8_UB(nxt) : cB;
        const int nt = cur.nt;
        for (int t = 0; t < nt; t += 2) {
            const bool last = (t == nt - 2);
            const char* a1 = cA + (size_t)(t + 1) * kstep;
            const char* a2 = last ? nA : cA + (size_t)(t + 2) * kstep; const char* b2 = last ? nB : cB + (size_t)(t + 2) * kstep;
            const char* a3 = a2 + kstep; const char* b3 = b2 + kstep;
            if constexpr (SP2) {
            PG8_LDB(B0, 0, 0); PG8_LDB(B1, 0, 1); PG8_SCHED; PG8_LDA(At, 0, 0); PG8_STAGE(PG8_SA(1, 1), a1 + hstep, voffA);
            PG8_WAIT_V(8); PG8_WAIT_L(0); PG8_BAR; PG8_MMA(0, 0, At, B0); PG8_MMA(0, 1, At, B1); PG8_BAR; PG8_SCHED;
            PG8_LDA(At, 0, 1); PG8_STAGE(PG8_SB(0, 0), b2, voffB); PG8_STAGE(PG8_SB(0, 1), b2 + hstep, voffB); PG8_STAGE(PG8_SA(0, 0), a2, voffA);
            PG8_WAIT_V(8); PG8_WAIT_L(0); PG8_BAR; PG8_MMA(1, 0, At, B0); PG8_MMA(1, 1, At, B1); PG8_BAR; PG8_SCHED;
            PG8_LDB(B0, 1, 0); PG8_LDB(B1, 1, 1); PG8_SCHED; PG8_LDA(At, 1, 0); PG8_STAGE(PG8_SA(0, 1), a2 + hstep, voffA);
            PG8_WAIT_V(8); PG8_WAIT_L(0); PG8_BAR; PG8_MMA(0, 0, At, B0); PG8_MMA(0, 1, At, B1); PG8_BAR; PG8_SCHED;
            PG8_LDA(At, 1, 1); PG8_STAGE(PG8_SB(1, 0), b3, voffB); PG8_STAGE(PG8_SB(1, 1), b3 + hstep, voffB); PG8_STAGE(PG8_SA(1, 0), a3, voffA);
            PG8_WAIT_V(8); PG8_WAIT_L(0); PG8_BAR; PG8_MMA(1, 0, At, B0); PG8_MMA(1, 1, At, B1); PG8_BAR; PG8_SCHED;
            } else {
            PG8_LDB(B0, 0, 0); PG8_SCHED; PG8_LDA(At, 0, 0); PG8_STAGE(PG8_SA(1, 1), a1 + hstep, voffA);
            PG8_WAIT_L(8); PG8_BAR; PG8_WAIT_L(0); PG8_MMA(0, 0, At, B0); PG8_BAR; PG8_SCHED;
            PG8_LDB(B1, 0, 1); PG8_STAGE(PG8_SB(0, 0), b2, voffB);
            PG8_BAR; PG8_WAIT_L(0); PG8_MMA(0, 1, At, B1); PG8_BAR;
            PG8_LDA(At, 0, 1); PG8_STAGE(PG8_SA(0, 0), a2, voffA);
            PG8_BAR; PG8_WAIT_L(0); PG8_MMA(1, 0, At, B0); PG8_BAR; PG8_SCHED;
            PG8_STAGE(PG8_SB(0, 1), b2 + hstep, voffB);
            PG8_WAIT_V(6); PG8_BAR; PG8_MMA(1, 1, At, B1); PG8_BAR;
            PG8_LDB(B0, 1, 0); PG8_SCHED; PG8_LDA(At, 1, 0); PG8_STAGE(PG8_SA(0, 1), a2 + hstep, voffA);
            PG8_WAIT_L(8); PG8_BAR; PG8_WAIT_L(0); PG8_MMA(0, 0, At, B0); PG8_BAR; PG8_SCHED;
            PG8_LDB(B1, 1, 1); PG8_STAGE(PG8_SB(1, 0), b3, voffB);
            PG8_BAR; PG8_WAIT_L(0); PG8_MMA(0, 1, At, B1); PG8_BAR;
            PG8_LDA(At, 1, 1); PG8_STAGE(PG8_SA(1, 0), a3, voffA);
            PG8_BAR; PG8_WAIT_L(0); PG8_MMA(1, 0, At, B0); PG8_BAR; PG8_SCHED;
            PG8_STAGE(PG8_SB(1, 1), b3 + hstep, voffB);
            PG8_WAIT_V(6); PG8_BAR; PG8_MMA(1, 1, At, B1); PG8_BAR;
            }
        }
        if constexpr (ALIGN_EPI) { if (wr == 0) PG8_BAR; }
        E(acc, cur, wr, wc, fr, fq);
        if (!has_next) break;
#pragma unroll
        for (int a = 0; a < 2; ++a)
#pragma unroll
            for (int b = 0; b < 2; ++b)
#pragma unroll
                for (int m = 0; m < 4; ++m)
#pragma unroll
                    for (int n = 0; n < 2; ++n) acc[a][b][m][n] = (f32x4){0.f, 0.f, 0.f, 0.f};
        cur = nxt; cA = nA; cB = nB; ++ui;
        if constexpr (ALIGN_EPI) { if (wr == 1) PG8_BAR; }
    }
    PG8_WAIT_V(0);
    if constexpr (!ALIGN_EPI) { if (wr == 0) PG8_BAR; }
    PG8_BAR;
#undef PG8_SA
#undef PG8_SB
#undef PG8_STAGE
#undef PG8_LDA
#undef PG8_LDB
#undef PG8_MMA
#undef PG8_WAIT_V
#undef PG8_WAIT_L
#undef PG8_BAR
#undef PG8_SCHED
#undef PG8_UA
#undef PG8_UB
}
}

#define LAS __attribute__((address_space(3)))
typedef unsigned short bf16;
typedef unsigned v4u __attribute__((ext_vector_type(4)));
typedef unsigned v2u __attribute__((ext_vector_type(2)));
typedef float f32x4 __attribute__((ext_vector_type(4)));
typedef float f32x2 __attribute__((ext_vector_type(2)));
typedef float f32x16 __attribute__((ext_vector_type(16)));
typedef short bf16x8 __attribute__((ext_vector_type(8)));
constexpr int NWAVES = 8, NTHREADS = 512;
constexpr int RING_BYTES = 131072, LDS_BYTES = 147456;

__device__ __forceinline__ unsigned pk2(float lo, float hi) { return pg8::cvt_pk_bf16(lo, hi); }
__device__ __forceinline__ float bflo(unsigned w) { return __uint_as_float(w << 16); }
__device__ __forceinline__ float bfhi(unsigned w) { return __uint_as_float(w & 0xffff0000u); }
__device__ __forceinline__ float wave_sum(float v) {
#pragma unroll
    for (int o = 1; o < 64; o <<= 1) v += __shfl_xor(v, o);
    return v;
}

constexpr size_t MiB = 1u << 20;
constexpr size_t WS_MOD = 0;
constexpr size_t WS_WIN = 1 * MiB, WS_WOUT = 25 * MiB, WS_WQK = 33 * MiB, WS_WV = 43 * MiB, WS_WO = 45 * MiB, WS_W1 = 53 * MiB, WS_W2 = 117 * MiB;
constexpr size_t WS_U = 181 * MiB, WS_H = 253 * MiB, WS_R1 = 397 * MiB, WS_PART = 685 * MiB, WS_SSP = 749 * MiB, WS_RSTD = 751 * MiB, WS_SHW = 752 * MiB, WS_END = 753 * MiB;
constexpr size_t WS_BAR = 880 * 1024;
constexpr size_t R1_B = 0, R1_Z = 72 * MiB, R1_V = 144 * MiB;
constexpr size_t R1_QK = 0, R1_VT = 90 * MiB, R1_O = 108 * MiB;
constexpr size_t W1_STRIDE = (size_t)FF * D, W2_STRIDE = (size_t)D * FF;

struct Args { const float* in[17]; float* out; unsigned char* ws; int ph_lo, ph_hi; };

__device__ __forceinline__ void transpose_item(const float* W, int ldw, int K, int k0, int n0, bf16* WT, int dest_base, int dest_stride, LAS float* scr, int lane) {
    {
        f32x4 v[8]; const int kr = lane >> 3, c4 = (lane & 7) * 4;
#pragma unroll
        for (int i = 0; i < 8; ++i) v[i] = __builtin_nontemporal_load((const f32x4*)(W + (size_t)(k0 + 8 * i + kr) * ldw + n0 + c4));
#pragma unroll
        for (int i = 0; i < 8; ++i) { LAS float* d = scr + (8 * i + kr) * 33 + c4; d[0] = v[i].x; d[1] = v[i].y; d[2] = v[i].z; d[3] = v[i].w; }
    }
    asm volatile("s_waitcnt lgkmcnt(0)" ::: "memory");
    const int c = lane & 7;
#pragma unroll
    for (int j = 0; j < 4; ++j) { const int n = (lane >> 3) + 8 * j; const LAS float* s = scr + (8 * c) * 33 + n;
        v4u o; o.x = pk2(s[0 * 33], s[1 * 33]); o.y = pk2(s[2 * 33], s[3 * 33]); o.z = pk2(s[4 * 33], s[5 * 33]); o.w = pk2(s[6 * 33], s[7 * 33]);
        *(v4u*)(WT + (size_t)(dest_base + dest_stride * n) * K + k0 + 8 * c) = o; }
    asm volatile("s_waitcnt lgkmcnt(0)" ::: "memory");
}

constexpr int I_IN = (D / 64) * (3 * D / 32), I_OUT = (D / 64) * (D / 32), I_QKV = (D / 64) * (3072 / 32), I_WO = I_OUT, I_W1 = (D / 64) * (FF / 32), I_W2 = (FF / 64) * (D / 32);
constexpr int TR_P0 = I_IN + I_QKV + I_W1 + I_W2, TR_T1 = TR_P0 + I_OUT + I_WO, TR_T2 = TR_T1 + I_W1 + I_W2;
__device__ __forceinline__ void transpose_dispatch(const Args& a, int r, LAS float* scr, int lane) {
    unsigned char* ws = a.ws;
    if (r < I_IN) { const int nblk = 3 * D / 32, kb = r / nblk, nb = r % nblk, n0 = 32 * nb; int dest;
        if (n0 < D) dest = n0; else if (n0 < 2 * D) { const int c = n0 - D; dest = D + 256 * (c >> 7) + (c & 127); } else { const int h = n0 - 2 * D; dest = D + 256 * (h >> 7) + 128 + (h & 127); }
        transpose_item(a.in[8], 3 * D, D, 64 * kb, n0, (bf16*)(ws + WS_WIN), dest, 1, scr, lane); return; } r -= I_IN;
    if (r < I_QKV) { const int nblk = 3072 / 32, kb = r / nblk, nb = r % nblk, n0 = 32 * nb;
        if (n0 < NQK) { const int hb = n0 & ~127, d0 = n0 & 127;
            transpose_item(a.in[11], 3072, D, 64 * kb, n0, (bf16*)(ws + WS_WQK), hb + 64 * (d0 >> 6) + ((d0 >> 5) & 1), 2, scr, lane); }
        else transpose_item(a.in[11], 3072, D, 64 * kb, n0, (bf16*)(ws + WS_WV), n0 - NQK, 1, scr, lane);
        return; } r -= I_QKV;
    if (r < I_W1) { const int nblk = FF / 32, kb = r / nblk, nb = r % nblk; transpose_item(a.in[14], FF, D, 64 * kb, 32 * nb, (bf16*)(ws + WS_W1), 32 * nb, 1, scr, lane); return; } r -= I_W1;
    if (r < I_W2) { const int nblk = D / 32, kb = r / nblk, nb = r % nblk; transpose_item(a.in[15], D, FF, 64 * kb, 32 * nb, (bf16*)(ws + WS_W2), 32 * nb, 1, scr, lane); return; } r -= I_W2;
    if (r < I_OUT) { const int nblk = D / 32, kb = r / nblk, nb = r % nblk; transpose_item(a.in[10], D, D, 64 * kb, 32 * nb, (bf16*)(ws + WS_WOUT), 32 * nb, 1, scr, lane); return; } r -= I_OUT;
    if (r < I_WO) { const int nblk = D / 32, kb = r / nblk, nb = r % nblk; transpose_item(a.in[13], D, D, 64 * kb, 32 * nb, (bf16*)(ws + WS_WO), 32 * nb, 1, scr, lane); return; } r -= I_WO;
    if (r < I_W1) { const int nblk = FF / 32, kb = r / nblk, nb = r % nblk; transpose_item(a.in[14] + (size_t)D * FF, FF, D, 64 * kb, 32 * nb, (bf16*)(ws + WS_W1) + W1_STRIDE, 32 * nb, 1, scr, lane); return; } r -= I_W1;
    { const int nblk = D / 32, kb = r / nblk, nb = r % nblk; transpose_item(a.in[15] + (size_t)FF * D, D, FF, 64 * kb, 32 * nb, (bf16*)(ws + WS_W2) + W2_STRIDE, 32 * nb, 1, scr, lane); }
}

__device__ __forceinline__ void p0_prologue(const Args& a, LAS unsigned char* lds) {
    const int tid = threadIdx.x, lane = tid & 63, wave = __builtin_amdgcn_readfirstlane(tid >> 6);
    const int G = gridDim.x;
    unsigned char* ws = a.ws;
    {
        LAS float* sc = (LAS float*)lds;
        LAS float* red = (LAS float*)(lds + 9 * D * 4);
        bool have = false;
        for (int t = blockIdx.x; t < 2 * (NMOD / 128); t += G) {
            if (!have) {
                for (int i = tid; i < 9 * D; i += NTHREADS) { const float v = i < 8 * D ? a.in[1][i] : a.in[3][i - 8 * D]; sc[i] = v / (1.f + __expf(-v)); }
                have = true;
            }
            __syncthreads();
            const int l = t / (NMOD / 128), cgp = t % (NMOD / 128);
            const float* w = a.in[6] + (size_t)l * D * NMOD + (size_t)(wave * 256) * NMOD + cgp * 128 + 2 * lane;
            float acc0[9], acc1[9];
#pragma unroll
            for (int r = 0; r < 9; ++r) { acc0[r] = 0.f; acc1[r] = 0.f; }
#pragma unroll 8
            for (int k = 0; k < 256; ++k) {
                const f32x2 wv = __builtin_nontemporal_load((const f32x2*)(w + (size_t)k * NMOD));
#pragma unroll
                for (int r = 0; r < 9; ++r) { const float s = sc[r * D + wave * 256 + k]; acc0[r] += s * wv.x; acc1[r] += s * wv.y; }
            }
#pragma unroll
            for (int r = 0; r < 9; ++r) { red[(wave * 9 + r) * 128 + 2 * lane] = acc0[r]; red[(wave * 9 + r) * 128 + 2 * lane + 1] = acc1[r]; }
            __syncthreads();
            for (int i = tid; i < 9 * 128; i += NTHREADS) { const int r = i >> 7, cc = i & 127; float s = 0.f;
#pragma unroll
                for (int w8 = 0; w8 < 8; ++w8) s += red[(w8 * 9 + r) * 128 + cc];
                ((float*)(ws + WS_MOD))[((size_t)l * 9 + r) * NMOD + cgp * 128 + cc] = s + a.in[7][(size_t)l * NMOD + cgp * 128 + cc]; }
        }
        __syncthreads();
    }
    LAS float* scr = (LAS float*)(lds + wave * 16384);
    const int ngemv = min(G, 2 * (NMOD / 128)), nfree = G - ngemv;
    constexpr int PRE = 4096;
    int pre = 0;
    if (nfree > 0) { pre = PRE; if ((int)blockIdx.x >= ngemv) for (int it = ((int)blockIdx.x - ngemv) * NWAVES + wave; it < PRE; it += nfree * NWAVES) transpose_dispatch(a, it, scr, lane); }
    for (int it = pre + blockIdx.x * NWAVES + wave; it < TR_P0; it += G * NWAVES) transpose_dispatch(a, it, scr, lane);
}
__device__ __forceinline__ void tail_transposes(const Args& a, LAS unsigned char* lds, int nunits, int lo, int hi) {
    const int lane = threadIdx.x & 63, wave = __builtin_amdgcn_readfirstlane(threadIdx.x >> 6), G = gridDim.x;
    const int first_idle = nunits % G, nidle = G - first_idle;
    if ((int)blockIdx.x < first_idle) return;
    LAS float* scr = (LAS float*)(lds + wave * 16384);
    for (int it = lo + ((int)blockIdx.x - first_idle) * NWAVES + wave; it < hi; it += nidle * NWAVES) transpose_dispatch(a, it, scr, lane);
}

__device__ __forceinline__ void norm_mod_phase(const float* lat, const float* ctx, int rbeg, int nrows, const float* g, const float* mod, int sh_idx, bf16* U,
                                               const float* part = nullptr, const float* pgate = nullptr, float* hctx_out = nullptr) {
    const int tid = threadIdx.x, lane = tid & 63, wave = __builtin_amdgcn_readfirstlane(tid >> 6);
    const int rpb = (nrows - rbeg + gridDim.x - 1) / gridDim.x, r0 = rbeg + blockIdx.x * rpb, r1 = min(nrows, r0 + rpb);
    f32x4 v[8], vn[8];
    { const int row = r0 + wave;
      if (row < r1) { const float* hr = row < ML ? lat + (size_t)row * D : ctx + (size_t)(row - ML) * D;
#pragma unroll
          for (int j = 0; j < 8; ++j) v[j] = __builtin_nontemporal_load((const f32x4*)(hr + 4 * lane + 256 * j)); } }
    for (int row = r0 + wave; row < r1; row += NWAVES) {
        const bool isc = row >= ML;
        const int mr = !isc ? row / SEQ : BATCH;
        const float* shp = mod + (size_t)mr * NMOD + (size_t)sh_idx * D; const float* sp = shp + D;
        float ss = 0.f;
        { const int nr = row + NWAVES;
          if (nr < r1) { const float* hn = nr < ML ? lat + (size_t)nr * D : ctx + (size_t)(nr - ML) * D;
#pragma unroll
              for (int j = 0; j < 8; ++j) vn[j] = __builtin_nontemporal_load((const f32x4*)(hn + 4 * lane + 256 * j)); } }
        if (isc && part) {
#pragma unroll
            for (int j = 0; j < 8; ++j) { const int c = 4 * lane + 256 * j; const float* pp = part + (size_t)(row - ML) * D + c;
                const f32x4 ps = (*(const f32x4*)pp + *(const f32x4*)(pp + (size_t)MC * D)) + (*(const f32x4*)(pp + (size_t)2 * MC * D) + *(const f32x4*)(pp + (size_t)3 * MC * D));
                v[j] = v[j] + *(const f32x4*)(pgate + c) * ps;
                if (hctx_out) *(f32x4*)(hctx_out + (size_t)(row - ML) * D + c) = v[j]; }
        }
#pragma unroll
        for (int j = 0; j < 8; ++j) ss += (v[j].x * v[j].x + v[j].y * v[j].y) + (v[j].z * v[j].z + v[j].w * v[j].w);
        const float rstd = rsqrtf(wave_sum(ss) * (1.f / D) + EPS);
#pragma unroll
        for (int j = 0; j < 8; ++j) { const int c = 4 * lane + 256 * j;
            const f32x4 gv = *(const f32x4*)(g + c), sv = *(const f32x4*)(sp + c), hv = *(const f32x4*)(shp + c);
            const f32x4 o = (v[j] * rstd) * gv * (sv + 1.f) + hv;
            v2u w; w.x = pk2(o.x, o.y); w.y = pk2(o.z, o.w); *(v2u*)(U + (size_t)row * D + c) = w; }
#pragma unroll
        for (int j = 0; j < 8; ++j) v[j] = vn[j];
    }
}
__device__ __forceinline__ void rstd_phase(const float* ssp, float* rstd, bool with_ctx) {
    const int nrows = with_ctx ? MT : ML;
    for (int row = blockIdx.x * NTHREADS + threadIdx.x; row < nrows; row += gridDim.x * NTHREADS) {
        float r = 1.f;
        if (row < ML) { const f32x4* p = (const f32x4*)(ssp + (size_t)row * 32); f32x4 a = p[0];
#pragma unroll
            for (int j = 1; j < 8; ++j) a = a + p[j];
            r = rsqrtf(((a.x + a.y) + (a.z + a.w)) * (1.f / D) + EPS); }
        rstd[row] = r;
    }
}
__device__ __forceinline__ void shw_phase(LAS unsigned char* lds, const float* mod, int sh_idx, const bf16* Wt, int N, float* shw) {
    const int tid = threadIdx.x, lane = tid & 63, wave = __builtin_amdgcn_readfirstlane(tid >> 6);
    LAS float* sh = (LAS float*)lds;
    __syncthreads();
    for (int i = tid; i < 8 * D / 4; i += NTHREADS) { const int r = i / (D / 4), c = (i % (D / 4)) * 4; *(LAS f32x4*)(sh + r * D + c) = *(const f32x4*)(mod + (size_t)r * NMOD + (size_t)sh_idx * D + c); }
    __syncthreads();
    for (int n = blockIdx.x * NWAVES + wave; n < N; n += gridDim.x * NWAVES) {
        float acc[8];
#pragma unroll
        for (int r = 0; r < 8; ++r) acc[r] = 0.f;
#pragma unroll 1
        for (int j = 0; j < 4; ++j) { const v4u w = *(const v4u*)(Wt + (size_t)n * D + 512 * j + 8 * lane);
            const float wf[8] = {bflo(w.x), bfhi(w.x), bflo(w.y), bfhi(w.y), bflo(w.z), bfhi(w.z), bflo(w.w), bfhi(w.w)};
#pragma unroll
            for (int r = 0; r < 8; ++r) { const f32x4 s0 = *(const LAS f32x4*)(sh + r * D + 512 * j + 8 * lane), s1 = *(const LAS f32x4*)(sh + r * D + 512 * j + 8 * lane + 4);
                acc[r] += (wf[0] * s0.x + wf[1] * s0.y) + (wf[2] * s0.z + wf[3] * s0.w) + (wf[4] * s1.x + wf[5] * s1.y) + (wf[6] * s1.z + wf[7] * s1.w); } }
#pragma unroll
        for (int r = 0; r < 8; ++r) { const float t = wave_sum(acc[r]); if (lane == r) shw[(size_t)r * N + n] = t; }
        if (lane == 8) shw[(size_t)8 * N + n] = 0.f;
    }
    __syncthreads();
}
__device__ __forceinline__ void final_norm_phase(const bf16* Hb, const float* g, float* out) {
    const int tid = threadIdx.x, lane = tid & 63, wave = __builtin_amdgcn_readfirstlane(tid >> 6);
    const int rpb = ML / gridDim.x, r0 = blockIdx.x * rpb, r1 = (blockIdx.x == gridDim.x - 1) ? ML : r0 + rpb;
    v4u v[4], vn[4];
    int row = r0 + wave;
    if (row < r1) {
#pragma unroll
        for (int j = 0; j < 4; ++j) v[j] = __builtin_nontemporal_load((const v4u*)(Hb + (size_t)row * D + 8 * lane + 512 * j));
    }
    for (; row < r1; row += NWAVES) {
        const int nr = row + NWAVES;
        if (nr < r1) {
#pragma unroll
            for (int j = 0; j < 4; ++j) vn[j] = __builtin_nontemporal_load((const v4u*)(Hb + (size_t)nr * D + 8 * lane + 512 * j));
        }
        float ss = 0.f;
#pragma unroll
        for (int j = 0; j < 4; ++j)
#pragma unroll
            for (int q = 0; q < 4; ++q) { const float a = bflo(v[j][q]), b2 = bfhi(v[j][q]); ss += a * a + b2 * b2; }
        const float rstd = rsqrtf(wave_sum(ss) * (1.f / D) + EPS);
#pragma unroll
        for (int j = 0; j < 4; ++j) { const int c = 8 * lane + 512 * j; const f32x4 g0 = *(const f32x4*)(g + c), g1 = *(const f32x4*)(g + c + 4);
            const f32x4 o0 = (f32x4){bflo(v[j].x), bfhi(v[j].x), bflo(v[j].y), bfhi(v[j].y)} * rstd * g0, o1 = (f32x4){bflo(v[j].z), bfhi(v[j].z), bflo(v[j].w), bfhi(v[j].w)} * rstd * g1;
            __builtin_nontemporal_store(o0, (f32x4*)(out + (size_t)row * D + c)); __builtin_nontemporal_store(o1, (f32x4*)(out + (size_t)row * D + c + 4)); }
#pragma unroll
        for (int j = 0; j < 4; ++j) v[j] = vn[j];
    }
}

__device__ __forceinline__ void conv_phase(const bf16* Bb, const bf16* Zb, const float* cw, bf16* V) {
    constexpr int R = 8, NTASK = (MT / R) * (D / 8);
    for (int task = blockIdx.x * NTHREADS + threadIdx.x; task < NTASK; task += gridDim.x * NTHREADS) {
        const int row0 = (task >> 8) * R, c = (task & 255) * 8;
        const int sl = row0 < ML ? SEQ : CTXL, s0 = row0 < ML ? (row0 & (SEQ - 1)) : ((row0 - ML) & (CTXL - 1));
        v4u z[R + 2], bb[R];
        z[0] = (v4u){0u, 0u, 0u, 0u}; z[R + 1] = (v4u){0u, 0u, 0u, 0u};
        if (s0 > 0) z[0] = *(const v4u*)(Zb + (size_t)(row0 - 1) * D + c);
#pragma unroll
        for (int i = 0; i < R; ++i) { z[i + 1] = *(const v4u*)(Zb + (size_t)(row0 + i) * D + c); bb[i] = __builtin_nontemporal_load((const v4u*)(Bb + (size_t)(row0 + i) * D + c)); }
        if (s0 + R < sl) z[R + 1] = *(const v4u*)(Zb + (size_t)(row0 + R) * D + c);
        const f32x4 w0a = *(const f32x4*)(cw + c), w0b = *(const f32x4*)(cw + c + 4), w1a = *(const f32x4*)(cw + D + c), w1b = *(const f32x4*)(cw + D + c + 4),
                    w2a = *(const f32x4*)(cw + 2 * D + c), w2b = *(const f32x4*)(cw + 2 * D + c + 4);
        const float w0[8] = {w0a.x, w0a.y, w0a.z, w0a.w, w0b.x, w0b.y, w0b.z, w0b.w}, w1[8] = {w1a.x, w1a.y, w1a.z, w1a.w, w1b.x, w1b.y, w1b.z, w1b.w},
                    w2[8] = {w2a.x, w2a.y, w2a.z, w2a.w, w2b.x, w2b.y, w2b.z, w2b.w};
#pragma unroll
        for (int i = 0; i < R; ++i) {
            v4u o;
#pragma unroll
            for (int q = 0; q < 4; ++q) {
                const float lo = bflo(bb[i][q]) * (w0[2 * q] * bflo(z[i][q]) + w1[2 * q] * bflo(z[i + 1][q]) + w2[2 * q] * bflo(z[i + 2][q]));
                const float hi = bfhi(bb[i][q]) * (w0[2 * q + 1] * bfhi(z[i][q]) + w1[2 * q + 1] * bfhi(z[i + 1][q]) + w2[2 * q + 1] * bfhi(z[i + 2][q]));
                o[q] = pk2(lo, hi);
            }
            *(v4u*)(V + (size_t)(row0 + i) * D + c) = o;
        }
    }
}

namespace att {
constexpr int KROW = 272, VROW = 144, KBUF = 64 * KROW, VBUF = 128 * VROW, BUF = KBUF + VBUF;
__device__ __forceinline__ int pi32(int i) { return (i & ~0xC) | ((i & 4) << 1) | ((i & 8) >> 1); }
__device__ __forceinline__ float hmax(float v) { auto rr = __builtin_amdgcn_permlane32_swap(__float_as_uint(v), __float_as_uint(v), false, false); return fmaxf(__uint_as_float(rr[0]), __uint_as_float(rr[1])); }
__device__ __forceinline__ float hsum(float v) { auto rr = __builtin_amdgcn_permlane32_swap(__float_as_uint(v), __float_as_uint(v), false, false); return __uint_as_float(rr[0]) + __uint_as_float(rr[1]); }

__device__ __forceinline__ void attn_phase(LAS unsigned char* lds, const bf16* QK, const bf16* VT, bf16* O, const float* sink) {
    const int tid = threadIdx.x, lane = tid & 63, wid = __builtin_amdgcn_readfirstlane(tid >> 6), r32 = lane & 31, hi = lane >> 5;
    for (int u = blockIdx.x; u < BATCH * 16 * 4 * 2; u += gridDim.x) {
        const int p = u & 1, hk = (u >> 1) & 3, n = (u >> 3) & 15, b = u >> 7;
        const int head = 4 * hk + 2 * p + (wid >> 2), a0 = 32 * (wid & 3);
        const int qtok = b * SEQ + 128 * n + a0 + r32;
        bf16x8 qf[8];
#pragma unroll
        for (int d0 = 0; d0 < 8; ++d0) qf[d0] = *(const bf16x8*)(QK + (size_t)qtok * NQK + head * 128 + 16 * d0 + 8 * hi);
        float m = sink[head] * LOG2E, l = hi == 0 ? 1.f : 0.f;
        f32x16 o[4];
#pragma unroll
        for (int i = 0; i < 4; ++i)
#pragma unroll
            for (int r = 0; r < 16; ++r) o[i][r] = 0.f;
        const int lo = n > 0 ? n - 1 : 0, hib = n < 15 ? n + 1 : 15, nloc = 2 * (hib - lo + 1), nt = nloc + 4;
        v4u kr[2], vr[2];
        auto load_tile = [&](int t) {
            const int ktok = t < nloc ? b * SEQ + 128 * (lo + (t >> 1)) + 64 * (t & 1) : ML + b * CTXL + 64 * (t - nloc);
#pragma unroll
            for (int i = 0; i < 2; ++i) { const int c = tid + 512 * i;
                kr[i] = *(const v4u*)(QK + (size_t)(ktok + (c >> 4)) * NQK + D + hk * 128 + (c & 15) * 8);
                vr[i] = *(const v4u*)(VT + (size_t)(hk * 128 + (c >> 3)) * MT + ktok + (c & 7) * 8); }
        };
        auto store_tile = [&](int buf) {
            LAS unsigned char* kb = lds + buf * BUF; LAS unsigned char* vb = kb + KBUF;
#pragma unroll
            for (int i = 0; i < 2; ++i) { const int c = tid + 512 * i;
                *(LAS v4u*)(kb + (c >> 4) * KROW + (c & 15) * 16) = kr[i];
                *(LAS v4u*)(vb + (c >> 3) * VROW + (c & 7) * 16) = vr[i]; }
        };
        load_tile(0); store_tile(0); __syncthreads();
        for (int t = 0; t < nt; ++t) {
            if (t + 1 < nt) load_tile(t + 1);
            const LAS unsigned char* kb = lds + (t & 1) * BUF; const LAS unsigned char* vb = kb + KBUF;
            const int kblk = t < nloc ? lo + (t >> 1) : n, c0t = 64 * (t & 1);
            const bool below = kblk < n, above = kblk > n;
            const bool dead = below ? (c0t + 63 < a0) : (above ? (c0t > a0 + 31) : false);
            const bool full = below ? (c0t >= a0 + 31) : (above ? (c0t + 63 <= a0) : true);
            if (!dead) {
            f32x16 s0, s1;
#pragma unroll
            for (int r = 0; r < 16; ++r) { s0[r] = 0.f; s1[r] = 0.f; }
            const int krow = pi32(r32);
#pragma unroll
            for (int d0 = 0; d0 < 8; ++d0) {
                const bf16x8 k0 = *(const LAS bf16x8*)(kb + krow * KROW + (2 * d0 + hi) * 16);
                const bf16x8 k1 = *(const LAS bf16x8*)(kb + (32 + krow) * KROW + (2 * d0 + hi) * 16);
                s0 = __builtin_amdgcn_mfma_f32_32x32x16_bf16(k0, qf[d0], s0, 0, 0, 0);
                s1 = __builtin_amdgcn_mfma_f32_32x32x16_bf16(k1, qf[d0], s1, 0, 0, 0);
            }
            if (!full) {
                const int a = a0 + r32, cb = c0t + 8 * hi;
#pragma unroll
                for (int r = 0; r < 16; ++r) { const int c0 = cb + 16 * (r >> 3) + (r & 7), c1 = c0 + 32;
                    const bool v0 = below ? (c0 >= a) : (c0 <= a), v1 = below ? (c1 >= a) : (c1 <= a);
                    s0[r] = v0 ? s0[r] : -1e30f; s1[r] = v1 ? s1[r] : -1e30f; }
            }
            float mx = fmaxf(s0[0], s1[0]);
#pragma unroll
            for (int r = 1; r < 16; ++r) mx = fmaxf(mx, fmaxf(s0[r], s1[r]));
            mx = hmax(mx);
            if (__any(mx > m)) {
                const float mn = fmaxf(m, mx), al = __builtin_amdgcn_exp2f(m - mn); m = mn; l *= al;
#pragma unroll
                for (int i = 0; i < 4; ++i)
#pragma unroll
                    for (int r = 0; r < 16; ++r) o[i][r] *= al;
            }
            float ps = 0.f;
#pragma unroll
            for (int r = 0; r < 16; ++r) { s0[r] = __builtin_amdgcn_exp2f(s0[r] - m); s1[r] = __builtin_amdgcn_exp2f(s1[r] - m); ps += s0[r] + s1[r]; }
            l += ps;
#pragma unroll
            for (int ks = 0; ks < 4; ++ks) {
                v4u pw;
                if (ks < 2) { const int q0 = 8 * (ks & 1); pw.x = pk2(s0[q0], s0[q0 + 1]); pw.y = pk2(s0[q0 + 2], s0[q0 + 3]); pw.z = pk2(s0[q0 + 4], s0[q0 + 5]); pw.w = pk2(s0[q0 + 6], s0[q0 + 7]); }
                else { const int q0 = 8 * (ks & 1); pw.x = pk2(s1[q0], s1[q0 + 1]); pw.y = pk2(s1[q0 + 2], s1[q0 + 3]); pw.z = pk2(s1[q0 + 4], s1[q0 + 5]); pw.w = pk2(s1[q0 + 6], s1[q0 + 7]); }
                const bf16x8 pb = __builtin_bit_cast(bf16x8, pw);
#pragma unroll
                for (int db = 0; db < 4; ++db) {
                    const bf16x8 vf = *(const LAS bf16x8*)(vb + (32 * db + r32) * VROW + (2 * ks + hi) * 16);
                    o[db] = __builtin_amdgcn_mfma_f32_32x32x16_bf16(vf, pb, o[db], 0, 0, 0);
                }
            }
            }
            if (t + 1 < nt) store_tile((t + 1) & 1);
            __syncthreads();
        }
        const float inv = 1.f / hsum(l);
        bf16* op = O + (size_t)qtok * D + head * 128 + 8 * hi;
#pragma unroll
        for (int db = 0; db < 4; ++db)
#pragma unroll
            for (int k = 0; k < 4; k += 2) {
                v2u a, b;
                a.x = pk2(o[db][4 * k] * inv, o[db][4 * k + 1] * inv); a.y = pk2(o[db][4 * k + 2] * inv, o[db][4 * k + 3] * inv);
                b.x = pk2(o[db][4 * k + 4] * inv, o[db][4 * k + 5] * inv); b.y = pk2(o[db][4 * k + 6] * inv, o[db][4 * k + 7] * inv);
                { auto r = __builtin_amdgcn_permlane32_swap(a.x, b.x, false, false); a.x = r[0]; b.x = r[1]; }
                { auto r = __builtin_amdgcn_permlane32_swap(a.y, b.y, false, false); a.y = r[0]; b.y = r[1]; }
                v4u w; w.x = a.x; w.y = a.y; w.z = b.x; w.w = b.y;
                *(v4u*)(op + 32 * db + 8 * k) = w; }
    }
}
}

#define XB_TMO      128
#define XB_XCNT(j)  (256  + 64 * (j))
#define XB_XSUB(j)  (1280 + 64 * (j))
#define XB_XGEN(j)  (2304 + 64 * (j))
#define XB_TOP      3328
#define XB_TOPGEN   3392
#define XCD_BAR_WORDS 3456
#define XB_SPIN_CAP (1u << 18)
__device__ __forceinline__ unsigned xb_ld(unsigned* p)              { return __hip_atomic_load(p, __ATOMIC_RELAXED, __HIP_MEMORY_SCOPE_AGENT); }
__device__ __forceinline__ unsigned xb_add(unsigned* p, unsigned v) { return __hip_atomic_fetch_add(p, v, __ATOMIC_RELAXED, __HIP_MEMORY_SCOPE_AGENT); }
__device__ __forceinline__ unsigned xb_xcc_id() { return (unsigned)__builtin_amdgcn_s_getreg((3 << 11) | 20) & 0xFu; }
#define XB_SPIN(cond, bar) do { unsigned _sp = 0; while (cond) { __builtin_amdgcn_s_sleep(1); \
    if ((++_sp & 255u) == 0u) { if (xb_ld(&(bar)[XB_TMO])) break; if (_sp > XB_SPIN_CAP) { atomicAdd(&(bar)[XB_TMO], 1u); break; } } } } while (0)
struct XcdBarrier { unsigned* bar; unsigned x; volatile LAS unsigned* st; };
__device__ __forceinline__ XcdBarrier xcd_barrier_post(unsigned* bar, volatile LAS unsigned* st) {
    XcdBarrier b; b.bar = bar; b.x = xb_xcc_id(); b.st = st;
    if (threadIdx.x == 0) (void)xb_add(&bar[XB_XCNT(b.x)], 1u);
    return b;
}
__device__ __forceinline__ void xcd_barrier_complete(unsigned* bar, unsigned x, unsigned& nloc, unsigned& nx) {
    const unsigned G = gridDim.x * gridDim.y * gridDim.z;
    unsigned sum, cnt, mine, sp = 0u;
    for (;;) {
        sum = 0u; cnt = 0u; mine = 0u;
#pragma unroll
        for (unsigned j = 0; j < 16; ++j) { const unsigned c = xb_ld(&bar[XB_XCNT(j)]); sum += c; cnt += (c > 0u) ? 1u : 0u; mine = (j == x) ? c : mine; }
        if (sum == G) break;
        __builtin_amdgcn_s_sleep(1);
        if ((++sp & 255u) == 0u) { if (xb_ld(&bar[XB_TMO])) break; if (sp > XB_SPIN_CAP) { atomicAdd(&bar[XB_TMO], 1u); break; } }
    }
    nloc = mine > 0u ? mine : 1u; nx = cnt > 0u ? cnt : 1u;
}
__device__ __forceinline__ void xcd_barrier(const XcdBarrier& b) {
    asm volatile("s_waitcnt vmcnt(0)" ::: "memory");
    __syncthreads();
    if (threadIdx.x == 0) {
        unsigned* bar = b.bar;
        __builtin_amdgcn_s_waitcnt(0);
        unsigned nloc = b.st[0], nx = b.st[1];
        if (nloc == 0u) { xcd_barrier_complete(bar, b.x, nloc, nx); b.st[0] = nloc; b.st[1] = nx; }
        const unsigned old = xb_add(&bar[XB_XSUB(b.x)], 1u);
        const unsigned gen = old / nloc;
        if (old + 1u == (gen + 1u) * nloc) {
            __builtin_amdgcn_fence(__ATOMIC_RELEASE, "agent");
            asm volatile("s_waitcnt vmcnt(0)" ::: "memory");
            const unsigned og = xb_add(&bar[XB_TOP], 1u);
            const unsigned tg = og / nx;
            if (og + 1u == (tg + 1u) * nx) xb_add(&bar[XB_TOPGEN], 1u);
            else XB_SPIN(xb_ld(&bar[XB_TOPGEN]) == tg, bar);
            __builtin_amdgcn_fence(__ATOMIC_ACQUIRE, "agent");
            xb_add(&bar[XB_XGEN(b.x)], 1u);
            asm volatile("s_waitcnt vmcnt(0)" ::: "memory");
        } else {
            XB_SPIN(xb_ld(&bar[XB_XGEN(b.x)]) == gen, bar);
            __builtin_amdgcn_fence(__ATOMIC_ACQUIRE, "agent");
            asm volatile("s_waitcnt vmcnt(0)" ::: "memory");
        }
    }
    __syncthreads();
}

constexpr int NPHASE = 16;
__global__ void __launch_bounds__(NTHREADS, 2) fwd_megakernel(Args args) {
    extern __shared__ __attribute__((aligned(16))) unsigned char lds_raw[];
    LAS unsigned char* lds = (LAS unsigned char*)lds_raw;
    cg::grid_group grid = cg::this_grid();
    unsigned char* ws = args.ws;
    const int lo = args.ph_lo, hi = args.ph_hi, G = gridDim.x, bx = blockIdx.x;
    const float* x = args.in[0]; const float* ctx = args.in[2];
    float* MOD = (float*)(ws + WS_MOD); bf16* Hb = (bf16*)(ws + WS_H);
    bf16* U = (bf16*)(ws + WS_U); bf16* R1 = (bf16*)(ws + WS_R1);
    bf16* Bb = (bf16*)(ws + WS_R1 + R1_B); bf16* Zb = (bf16*)(ws + WS_R1 + R1_Z); bf16* Vb = (bf16*)(ws + WS_R1 + R1_V);
    bf16* QKb = (bf16*)(ws + WS_R1 + R1_QK); bf16* VTb = (bf16*)(ws + WS_R1 + R1_VT); bf16* Ob = (bf16*)(ws + WS_R1 + R1_O);
    const float* MOD0 = MOD; const float* MOD1 = MOD + 9 * NMOD;
#define IN(k) (lo <= (k) && (k) < hi)
#define SEAM(k) do { if (IN(k) && IN((k) + 1)) xcd_barrier(bar); } while (0)
    typedef pg8::StaticOrder SO;
    unsigned* barw = (unsigned*)(ws + WS_BAR);
    volatile LAS unsigned* MISC = (volatile LAS unsigned*)(lds + RING_BYTES);
    if (threadIdx.x < 16) MISC[threadIdx.x] = 0u;
    __syncthreads();
    XcdBarrier bar; bar.bar = barw; bar.x = 0; bar.st = MISC + 8;
    float* PART = (float*)(ws + WS_PART);
    float* Hc = (float*)(ws + WS_H + 64 * MiB);

    if (IN(0)) {
        if (bx == 0) for (int i = threadIdx.x; i < XCD_BAR_WORDS; i += NTHREADS) barw[i] = 0u;
        p0_prologue(args, lds);
        if (IN(1)) { grid.sync(); bar = xcd_barrier_post(barw, MISC + 8); }
    }
    float* SSP = (float*)(ws + WS_SSP); float* RSTD = (float*)(ws + WS_RSTD);
    float* SHWA = (float*)(ws + WS_SHW); float* SHWB = SHWA + 9 * FF; float* SHWC = SHWB + 9 * 3072;
    const float* MODC = MOD0 + (size_t)BATCH * NMOD;
    if (IN(1)) { norm_mod_phase(x, ctx, 0, MT, args.in[4], MOD0, 0, U);
        shw_phase(lds, MOD0, 3, (const bf16*)(ws + WS_W1), FF, SHWA); shw_phase(lds, MOD1, 0, (const bf16*)(ws + WS_WQK), 3072, SHWB); } SEAM(1);
    if (IN(2)) { pg8::Gemm g{U, (const bf16*)(ws + WS_WIN), nullptr, nullptr, D}; SO S; S.init(MT, 3 * D, D, G, bx); pg8::EpiConvIn E{Bb, Zb};
        pg8::gemm_phase<pg8::EpiConvIn, SO, true, true>(lds, g, S, E); tail_transposes(args, lds, (MT / 256) * (3 * D / 256), TR_P0, TR_T1); } SEAM(2);
    if (IN(3)) { conv_phase(Bb, Zb, args.in[9], Vb); } SEAM(3);
    if (IN(4)) { pg8::Gemm g{Vb, (const bf16*)(ws + WS_WOUT), nullptr, nullptr, D};
        { SO S; S.init(ML, D, D, G, bx); pg8::EpiResid<true, false> E{x, Hb, MOD0 + 2 * D, args.in[5], MOD0 + 4 * D, U, SSP}; pg8::gemm_phase<pg8::EpiResid<true, false>, SO, true, true>(lds, g, S, E); }
        { pg8::QuarterOrder S; S.init(D, G, bx); pg8::EpiPart E{PART, D / 4}; pg8::gemm_phase<pg8::EpiPart, pg8::QuarterOrder, true, true>(lds, g, S, E); } } SEAM(4);
    if (IN(5)) { norm_mod_phase(nullptr, ctx, ML, MT, args.in[5], MOD0, 3, U, PART, MODC + 2 * D, Hc); rstd_phase(SSP, RSTD, true); } SEAM(5);
    if (IN(6)) { pg8::Gemm g{U, (const bf16*)(ws + WS_W1), nullptr, nullptr, D}; SO S; S.init(MT, FF, D, G, bx); pg8::EpiRelu2 E{R1, RSTD, SHWA};
        pg8::gemm_phase<pg8::EpiRelu2, SO, true, true>(lds, g, S, E); } SEAM(6);
    if (IN(7)) { pg8::Gemm g{R1, (const bf16*)(ws + WS_W2), nullptr, nullptr, FF};
        { SO S; S.init(ML, D, FF, G, bx); pg8::EpiResid<true, true> E{Hb, Hb, MOD0 + 5 * D, args.in[4] + D, MOD1 + 1 * D, U, SSP}; pg8::gemm_phase<pg8::EpiResid<true, true>, SO, true, true>(lds, g, S, E); }
        { pg8::QuarterOrder S; S.init(FF, G, bx); pg8::EpiPart E{PART, FF / 4}; pg8::gemm_phase<pg8::EpiPart, pg8::QuarterOrder, true, true>(lds, g, S, E); } } SEAM(7);
    if (IN(8)) { norm_mod_phase(nullptr, Hc, ML, MT, args.in[4] + D, MOD1, 0, U, PART, MODC + 5 * D, nullptr); rstd_phase(SSP, RSTD, true); } SEAM(8);
    if (IN(9)) { pg8::Gemm g{U, (const bf16*)(ws + WS_WQK), (const bf16*)(ws + WS_WV), U, D}; pg8::QkvOrder S; S.init(G, bx); pg8::EpiQkv E{QKb, VTb, RSTD, SHWB};
        pg8::gemm_phase<pg8::EpiQkv, pg8::QkvOrder, true, true>(lds, g, S, E); tail_transposes(args, lds, (MT / 256) * (NQK / 256) + 2 * (MT / 256), TR_T1, TR_T2); } SEAM(9);
    if (IN(10)) { att::attn_phase(lds, QKb, VTb, Ob, args.in[12]); } SEAM(10);
    if (IN(11)) { pg8::Gemm g{Ob, (const bf16*)(ws + WS_WO), nullptr, nullptr, D}; SO S; S.init(ML, D, D, G, bx); pg8::EpiResid<true, true> E{Hb, Hb, MOD1 + 2 * D, args.in[5] + D, MOD1 + 4 * D, U, SSP};
        pg8::gemm_phase<pg8::EpiResid<true, true>, SO, true, true>(lds, g, S, E); } SEAM(11);
    if (IN(12)) { rstd_phase(SSP, RSTD, false); shw_phase(lds, MOD1, 3, (const bf16*)(ws + WS_W1) + W1_STRIDE, FF, SHWC); } SEAM(12);
    if (IN(13)) { pg8::Gemm g{U, (const bf16*)(ws + WS_W1) + W1_STRIDE, nullptr, nullptr, D}; SO S; S.init(ML, FF, D, G, bx); pg8::EpiRelu2 E{R1, RSTD, SHWC};
        pg8::gemm_phase<pg8::EpiRelu2, SO, true, true>(lds, g, S, E); } SEAM(13);
    if (IN(14)) { pg8::Gemm g{R1, (const bf16*)(ws + WS_W2) + W2_STRIDE, nullptr, nullptr, FF}; SO S; S.init(ML, D, FF, G, bx); pg8::EpiResid<false, true> E{Hb, Hb, MOD1 + 5 * D, nullptr, nullptr, nullptr, nullptr};
        pg8::gemm_phase<pg8::EpiResid<false, true>, SO, true, true>(lds, g, S, E); } SEAM(14);
    if (IN(15)) { final_norm_phase(Hb, args.in[16], args.out); }
#undef IN
#undef SEAM
}

extern "C" void kernel_launch(void* const* d_in, const int* in_sizes, int n_in, void* d_out, int out_size, void* d_ws, size_t ws_size, hipStream_t stream) {
    static int grid = 0;
    if (grid == 0) {
        if (n_in != 17 || in_sizes[0] != ML * D || out_size != ML * D || ws_size < WS_END) { fprintf(stderr, "kernel_launch: unexpected shapes (n_in %d, in0 %d, out %d, ws %zu); nothing launched\n", n_in, n_in > 0 ? in_sizes[0] : -1, out_size, ws_size); grid = -1; return; }
        int dev = 0, cus = 0, per_cu = 0;
        if (hipGetDevice(&dev) != hipSuccess || hipDeviceGetAttribute(&cus, hipDeviceAttributeMultiprocessorCount, dev) != hipSuccess) { grid = -1; return; }
        if (hipFuncSetAttribute((const void*)fwd_megakernel, hipFuncAttributeMaxDynamicSharedMemorySize, LDS_BYTES) != hipSuccess) { fprintf(stderr, "kernel_launch: hipFuncSetAttribute failed\n"); grid = -1; return; }
        if (hipOccupancyMaxActiveBlocksPerMultiprocessor(&per_cu, (const void*)fwd_megakernel, NTHREADS, LDS_BYTES) != hipSuccess || per_cu < 1) { fprintf(stderr, "kernel_launch: occupancy query gives %d\n", per_cu); per_cu = 1; }
        (void)hipGetLastError();
        grid = cus * 1;
    }
    if (grid < 0) return;
    Args a{};
    for (int i = 0; i < 17; ++i) a.in[i] = (const float*)d_in[i];
    a.out = (float*)d_out; a.ws = (unsigned char*)d_ws;
    if (MK_N_LAUNCHES == 1) {
        a.ph_lo = 0; a.ph_hi = NPHASE;
        void* kargs[] = {&a};
        hipError_t e = hipLaunchCooperativeKernel((const void*)fwd_megakernel, dim3(grid), dim3(NTHREADS), kargs, LDS_BYTES, stream);
        if (e != hipSuccess) fprintf(stderr, "kernel_launch: cooperative launch failed: %s (grid %d)\n", hipGetErrorString(e), grid);
    } else {
        for (int p = 0; p < NPHASE; ++p) { a.ph_lo = p; a.ph_hi = p + 1; hipLaunchKernelGGL(fwd_megakernel, dim3(grid), dim3(NTHREADS), LDS_BYTES, stream, a); }
    }
}
```
